# Optimizing an MI355X kernel written in HIP

```python
import math
import jax, jax.numpy as jnp
from jax import lax
import numpy as np

D_MODEL = 1024
BATCH = 8
SEQ = 4096
DEPTH = 2

HEAD_DIM = 64
DIL_GROUPS = ((128, 1), (512, 4), (2048, 16))
HEADS_PER_GROUP = 4
N_GROUPS = len(DIL_GROUPS)
N_HEADS_A = HEADS_PER_GROUP * N_GROUPS
N_HEADS_B = 4
WIDTH_A = N_HEADS_A * HEAD_DIM
WIDTH_A_OUT = HEADS_PER_GROUP * HEAD_DIM
WIDTH_B = N_HEADS_B * HEAD_DIM
N_BRANCH = 2
SPLIT_SIZES = (WIDTH_A, WIDTH_A, WIDTH_A, WIDTH_B, WIDTH_B, WIDTH_B, N_HEADS_B, D_MODEL, D_MODEL)
SPLIT_POINTS = tuple(int(v) for v in np.cumsum(SPLIT_SIZES)[:-1])
D_IN = int(sum(SPLIT_SIZES))
D_FF = -(-8 * D_MODEL // (3 * 256)) * 256
BLOCK = 128
ALIBI_MAX = 8.0
EPS = 1e-6
N_MOD = 6

kernel_name = "hybrid_dilated_fox_adaln_block"


def rms_norm(x, g):
    xf = x.astype(jnp.float32)
    y = xf * lax.rsqrt(jnp.mean(xf * xf, axis=-1, keepdims=True) + EPS)
    return (y * g.astype(jnp.float32)).astype(x.dtype)


def alibi_slopes():
    h = np.arange(1, N_HEADS_A + 1, dtype=np.float32)
    return jnp.asarray(2.0 ** (-ALIBI_MAX * h / N_HEADS_A), dtype=jnp.float32)


def dilated_group_attention(q, k, v, window, dilation, slopes):
    B, S, H, Dh = q.shape
    L = S // dilation
    nb = -(-L // BLOCK)
    Lp = nb * BLOCK
    pad_end = Lp - L

    def split(t):
        return t.reshape(B, L, dilation, H, Dh).transpose(0, 2, 1, 3, 4)

    def band(t):
        t = jnp.pad(split(t), ((0, 0), (0, 0), (BLOCK, pad_end), (0, 0), (0, 0)))
        t = t.reshape(B, dilation, nb + 1, BLOCK, H, Dh)
        return jnp.concatenate([t[:, :, :-1], t[:, :, 1:]], axis=3)

    qb = jnp.pad(split(q), ((0, 0), (0, 0), (0, pad_end), (0, 0), (0, 0)))
    qb = qb.reshape(B, dilation, nb, BLOCK, H, Dh)
    kb, vb = band(k), band(v)

    scores = jnp.einsum('brnqhd,brnkhd->brnhqk', qb, kb).astype(jnp.float32) * (Dh ** -0.5)
    qi = jnp.arange(BLOCK)[:, None]
    kj = jnp.arange(2 * BLOCK)[None, :]
    dist = qi + BLOCK - kj
    kpos = jnp.arange(nb)[:, None, None] * BLOCK + kj[None] - BLOCK
    valid = (dist >= 0) & (dist <= window // dilation) & (kpos >= 0)
    bias = -slopes[:, None, None] * (dist * dilation).astype(jnp.float32)[None]
    logits = jnp.where(valid[None, None, :, None], scores + bias, -jnp.inf)
    lse = jax.nn.logsumexp(logits, axis=-1)
    p = jnp.exp(logits - lse[..., None])
    out = jnp.einsum('brnhqk,brnkhd->brnqhd', p.astype(v.dtype), vb)
    out = out.reshape(B, dilation, Lp, H, Dh)[:, :, :L].transpose(0, 2, 1, 3, 4).reshape(B, S, H, Dh)
    lse = lse.transpose(0, 1, 2, 4, 3).reshape(B, dilation, Lp, H)[:, :, :L]
    lse = lse.transpose(0, 2, 1, 3).reshape(B, S, H)
    return out, lse


def dilated_mixture(qa, ka, va):
    B, S, _ = qa.shape
    shp = (B, S, N_HEADS_A, HEAD_DIM)
    qa, ka, va = qa.reshape(shp), ka.reshape(shp), va.reshape(shp)
    slopes = alibi_slopes()
    outs, lses = [], []
    for g, (w, d) in enumerate(DIL_GROUPS):
        sl = slice(g * HEADS_PER_GROUP, (g + 1) * HEADS_PER_GROUP)
        o, l = dilated_group_attention(qa[:, :, sl], ka[:, :, sl], va[:, :, sl], w, d, slopes[sl])
        outs.append(o)
        lses.append(l)
    outs = jnp.stack(outs, axis=0)
    alpha = jax.nn.softmax(jnp.stack(lses, axis=0), axis=0)
    y = jnp.sum(alpha[..., None].astype(outs.dtype) * outs, axis=0)
    return y.reshape(B, S, WIDTH_A_OUT)


def forgetting_attention(qb, kb, vb, f_logit, b_forget):
    B, S, _ = qb.shape
    H, Dh = N_HEADS_B, HEAD_DIM
    q = qb.reshape(B, S, H, Dh)
    k = kb.reshape(B, S, H, Dh)
    v = vb.reshape(B, S, H, Dh)
    log_f = jax.nn.log_sigmoid(f_logit.astype(jnp.float32) + b_forget.astype(jnp.float32))
    F = jnp.cumsum(log_f, axis=1).transpose(0, 2, 1)
    nb = S // BLOCK
    q_blocks = q.reshape(B, nb, BLOCK, H, Dh).transpose(1, 0, 2, 3, 4)
    F_blocks = F.reshape(B, H, nb, BLOCK).transpose(2, 0, 1, 3)
    kpos = jnp.arange(S)
    scale = Dh ** -0.5

    def one_block(args):
        i, qi, Fi = args
        s = jnp.einsum('bqhd,bkhd->bhqk', qi, k).astype(jnp.float32) * scale
        s = s + (Fi[..., :, None] - F[..., None, :])
        qpos = i * BLOCK + jnp.arange(BLOCK)
        s = jnp.where(kpos[None, :] <= qpos[:, None], s, -jnp.inf)
        p = jax.nn.softmax(s, axis=-1)
        return jnp.einsum('bhqk,bkhd->bqhd', p.astype(v.dtype), v)

    out = lax.map(one_block, (jnp.arange(nb), q_blocks, F_blocks))
    return out.transpose(1, 0, 2, 3, 4).reshape(B, S, H * Dh)


def token_mixer(h, w_in, b_forget, w_up_a, w_up_b, w_out):
    z = h @ w_in
    qa, ka, va, qb, kb, vb, fz, gza, gzb = jnp.split(z, SPLIT_POINTS, axis=-1)
    ya = dilated_mixture(qa, ka, va) @ w_up_a
    yb = forgetting_attention(qb, kb, vb, fz, b_forget) @ w_up_b
    merged = jax.nn.sigmoid(gza) * ya + jax.nn.sigmoid(gzb) * yb
    return merged @ w_out


def swiglu(h, w_ffn_in, w_ffn_out):
    gate, up = jnp.split(h @ w_ffn_in, 2, axis=-1)
    return (jax.nn.silu(gate) * up) @ w_ffn_out


def setup_inputs(seed: int = 0) -> dict:
    key = jax.random.key(seed)
    ks = jax.random.split(key, 16)
    f32 = jnp.float32
    nrm = lambda k, shape, s: jax.random.normal(k, shape, f32) * s
    x = jax.random.normal(ks[0], (BATCH, SEQ, D_MODEL), f32)
    c = jax.random.normal(ks[1], (BATCH, D_MODEL), f32)
    w_ada = nrm(ks[2], (DEPTH, D_MODEL, N_MOD * D_MODEL), 0.5 * D_MODEL ** -0.5)
    b_ada = nrm(ks[3], (DEPTH, N_MOD * D_MODEL), 0.02)
    norm_mix = 1.0 + nrm(ks[4], (DEPTH, D_MODEL), 0.02)
    w_in = nrm(ks[5], (DEPTH, D_MODEL, D_IN), D_MODEL ** -0.5)
    b_forget = jnp.linspace(1.0, 5.0, N_HEADS_B, dtype=f32)[None] + nrm(ks[6], (DEPTH, N_HEADS_B), 0.1)
    w_up_a = nrm(ks[7], (DEPTH, WIDTH_A_OUT, D_MODEL), WIDTH_A_OUT ** -0.5)
    w_up_b = nrm(ks[8], (DEPTH, WIDTH_B, D_MODEL), WIDTH_B ** -0.5)
    w_out = nrm(ks[9], (DEPTH, D_MODEL, D_MODEL), D_MODEL ** -0.5)
    norm_ffn = 1.0 + nrm(ks[10], (DEPTH, D_MODEL), 0.02)
    w_ffn_in = nrm(ks[11], (DEPTH, D_MODEL, 2 * D_FF), D_MODEL ** -0.5)
    w_ffn_out = nrm(ks[12], (DEPTH, D_FF, D_MODEL), D_FF ** -0.5)
    norm_final = 1.0 + nrm(ks[13], (D_MODEL,), 0.02)
    return {"x": x, "c": c, "w_ada": w_ada, "b_ada": b_ada, "norm_mix": norm_mix,
            "w_in": w_in, "b_forget": b_forget, "w_up_a": w_up_a, "w_up_b": w_up_b,
            "w_out": w_out, "norm_ffn": norm_ffn, "w_ffn_in": w_ffn_in,
            "w_ffn_out": w_ffn_out, "norm_final": norm_final}


def reference(x, c, w_ada, b_ada, norm_mix, w_in, b_forget, w_up_a, w_up_b, w_out,
              norm_ffn, w_ffn_in, w_ffn_out, norm_final):
    c_act = jax.nn.silu(c)
    for l in range(DEPTH):
        mod = c_act @ w_ada[l] + b_ada[l]
        sh1, sc1, g1, sh2, sc2, g2 = [m[:, None, :] for m in jnp.split(mod, N_MOD, axis=-1)]
        h = rms_norm(x, norm_mix[l]) * (1.0 + sc1) + sh1
        x = x + g1 * token_mixer(h, w_in[l], b_forget[l], w_up_a[l], w_up_b[l], w_out[l])
        h = rms_norm(x, norm_ffn[l]) * (1.0 + sc2) + sh2
        x = x + g2 * swiglu(h, w_ffn_in[l], w_ffn_out[l])
    return rms_norm(x, norm_final)
```

```cpp
#include <hip/hip_runtime.h>
#include <hip/hip_cooperative_groups.h>
#include <cstdio>
#include <cstdint>
namespace cg = cooperative_groups;

#ifndef MK_MULTI
#define MK_MULTI 0
#endif

#define LAS __attribute__((address_space(3)))
typedef unsigned short bf16_t;
typedef short bf16x8 __attribute__((ext_vector_type(8)));
typedef short s16x4 __attribute__((ext_vector_type(4)));
typedef float f32x4 __attribute__((ext_vector_type(4)));
typedef float f32x2 __attribute__((ext_vector_type(2)));
typedef float f32x16 __attribute__((ext_vector_type(16)));
typedef unsigned u32x4 __attribute__((ext_vector_type(4)));
typedef unsigned u32x2 __attribute__((ext_vector_type(2)));
typedef __bf16 bf16x2_t __attribute__((ext_vector_type(2)));

__device__ __forceinline__ unsigned cvtpk(float lo, float hi) { f32x2 v = {lo, hi}; bf16x2_t b = __builtin_convertvector(v, bf16x2_t); return __builtin_bit_cast(unsigned, b); }
__device__ __forceinline__ float bf_lo(unsigned w) { return __uint_as_float(w << 16); }
__device__ __forceinline__ float bf_hi(unsigned w) { return __uint_as_float(w & 0xffff0000u); }
__device__ __forceinline__ float sigmoidf_fast(float x) { return __builtin_amdgcn_rcpf(1.0f + __builtin_amdgcn_exp2f(-1.4426950408889634f * x)); }

namespace pg8 {
constexpr int BM = 256, BK = 64, HALF = 128, HTB = HALF * BK * 2, STAGE_BYTES = 8 * HTB, NXCD = 8, WGM = 8;
__host__ __device__ __forceinline__ int lds_byte(int r, int c) { const int st = (r >> 4) * 2 + (c >> 5), rr = r & 15, cc = c & 31, ob = rr * 64 + cc * 2; return st * 1024 + (ob ^ (((ob >> 9) & 1) << 5)); }
__host__ __device__ __forceinline__ void stage_rc(int b, int& R, int& C) { const int st = b / 1024, sb = b % 1024, swz = sb ^ (((sb >> 9) & 1) << 5); R = (st >> 1) * 16 + swz / 64; C = (st & 1) * 32 + (swz % 64) / 2; }
__host__ __device__ __forceinline__ int perm32(int rho) { const int n = rho >> 4, i = rho & 15; return 8 * (i >> 2) + 4 * n + (i & 3); }
struct Unit { int pm, pn; };
struct Gemm { const bf16_t* A; const bf16_t* Bt; int M, N, K; int zskip; };
struct StaticOrder {
    int nM, nN, nwg, G, c, rot;
    __host__ __device__ void init(int M, int N, int G_, int c_, int rot_ = 0) { nM = M / BM; nN = N / BM; nwg = nM * nN; G = G_; c = c_; rot = rot_; }
    __host__ __device__ bool next(int i, Unit& u) const {
        const long L = (long)i * G + c; if (L >= nwg) return false;
        int wgid = (int)L; { const int q = nwg / NXCD, r = nwg % NXCD, xcd = wgid % NXCD, off = wgid / NXCD; wgid = (xcd < r ? xcd * (q + 1) : r * (q + 1) + (xcd - r) * q) + off; }
        const int nig = WGM * nN, gid = wgid / nig, fm = gid * WGM, gsz = (nM - fm) < WGM ? (nM - fm) : WGM;
        u.pm = fm + ((wgid % nig) % gsz); u.pn = (wgid % nig) / gsz + rot; if (u.pn >= nN) u.pn -= nN; return true;
    }
    __device__ __forceinline__ void a_ready(const Unit&) const {}
    __device__ __forceinline__ void done(const Unit&) const {}
};

template <class Epi, class Sched, bool ALIGN_EPI = false, bool SP2 = false, bool ZSKIP = false>
__device__ __forceinline__ void gemm_phase(LAS unsigned char* lds, const Gemm g, const Sched& S, const Epi& E, const int tid) {
    const int wid = __builtin_amdgcn_readfirstlane(tid >> 6), lane = tid & 63, wr = wid >> 2, wc = wid & 3, fr = lane & 15, fq = lane >> 4;
    const int K = g.K, nt = K / BK;
    unsigned voffA[2], voffB[2];
#pragma unroll
    for (int i = 0; i < 2; ++i) { int R, C; stage_rc(tid * 16 + i * 8192, R, C); const int Rb = Epi::PERM ? ((R & ~31) + perm32(R & 31)) : R;
        voffA[i] = (unsigned)(R * K + C) * 2u; voffB[i] = (unsigned)(Rb * K + C) * 2u; }
    const size_t kstep = (size_t)(BK * 2);
    const size_t hstep = (size_t)HALF * K * 2;
    const size_t tstep = 2 * hstep;
    const unsigned ldsw = (unsigned)wid * 1024u;
    const int aoff = lds_byte(wr * 64 + fr, fq * 8), boff = lds_byte(wc * 32 + fr, fq * 8);
#define PG8_SA(b, h) (((b) * 2 + (h)) * HTB)
#define PG8_SB(b, h) ((4 + (b) * 2 + (h)) * HTB)
#define PG8_STAGE(bufoff, gbase, voff) do { _Pragma("unroll") for (int _i = 0; _i < 2; ++_i) \
        __builtin_amdgcn_global_load_lds((const unsigned*)((const char*)(gbase) + (voff)[_i]), (LAS unsigned*)(lds + (bufoff) + ldsw + _i * 8192), 16, 0, 0); } while (0)
#define PG8_LDA(dst, b, h) do { _Pragma("unroll") for (int m = 0; m < 4; ++m) _Pragma("unroll") for (int k = 0; k < 2; ++k) dst[m][k] = *(const LAS bf16x8*)(lds + PG8_SA(b, h) + aoff + m * 2048 + k * 1024); } while (0)
#define PG8_LDB(dst, b, h) do { _Pragma("unroll") for (int n = 0; n < 2; ++n) _Pragma("unroll") for (int k = 0; k < 2; ++k) dst[n][k] = *(const LAS bf16x8*)(lds + PG8_SB(b, h) + boff + n * 2048 + k * 1024); } while (0)
#define PG8_MMA(ai, bj, At, Bt) do { __builtin_amdgcn_s_setprio(1); _Pragma("unroll") for (int m = 0; m < 4; ++m) _Pragma("unroll") for (int n = 0; n < 2; ++n) _Pragma("unroll") for (int k = 0; k < 2; ++k) \
        acc[ai][bj][m][n] = __builtin_amdgcn_mfma_f32_16x16x32_bf16(Bt[n][k], At[m][k], acc[ai][bj][m][n], 0, 0, 0); __builtin_amdgcn_s_setprio(0); } while (0)
#define PG8_WAIT_V(n) asm volatile("s_waitcnt vmcnt(" #n ")" ::: "memory")
#define PG8_WAIT_L(n) asm volatile("s_waitcnt lgkmcnt(" #n ")" ::: "memory")
#define PG8_BAR __builtin_amdgcn_s_barrier()
#define PG8_SCHED __builtin_amdgcn_sched_barrier(0)
    Unit cur, nxt; int ui = 0;
    if (!S.next(0, cur)) return;
    f32x4 acc[2][2][4][2];
#pragma unroll
    for (int a = 0; a < 2; ++a)
#pragma unroll
        for (int b = 0; b < 2; ++b)
#pragma unroll
            for (int m = 0; m < 4; ++m)
#pragma unroll
                for (int n = 0; n < 2; ++n) acc[a][b][m][n] = (f32x4){0.f, 0.f, 0.f, 0.f};
    bf16x8 At[4][2], B0[2][2], B1[2][2];
    const char* cA = (const char*)g.A + (size_t)cur.pm * tstep; const char* cB = (const char*)g.Bt + (size_t)cur.pn * tstep;
    S.a_ready(cur);
    if constexpr (SP2) {
        PG8_STAGE(PG8_SB(0, 0), cB, voffB); PG8_STAGE(PG8_SB(0, 1), cB + hstep, voffB); PG8_STAGE(PG8_SA(0, 0), cA, voffA); PG8_STAGE(PG8_SA(0, 1), cA + hstep, voffA);
        if (wr == 1) PG8_BAR;
        PG8_WAIT_V(2); PG8_BAR;
        PG8_STAGE(PG8_SB(1, 0), cB + kstep, voffB); PG8_STAGE(PG8_SA(1, 0), cA + kstep, voffA); PG8_STAGE(PG8_SB(1, 1), cB + hstep + kstep, voffB);
        PG8_WAIT_V(6); PG8_BAR;
    } else {
        PG8_STAGE(PG8_SB(0, 0), cB, voffB); PG8_STAGE(PG8_SA(0, 0), cA, voffA); PG8_STAGE(PG8_SB(0, 1), cB + hstep, voffB); PG8_STAGE(PG8_SA(0, 1), cA + hstep, voffA);
        if (wr == 1) PG8_BAR;
        PG8_WAIT_V(4); PG8_BAR;
        PG8_STAGE(PG8_SB(1, 0), cB + kstep, voffB); PG8_STAGE(PG8_SA(1, 0), cA + kstep, voffA); PG8_STAGE(PG8_SB(1, 1), cB + hstep + kstep, voffB);
        PG8_WAIT_V(6); PG8_BAR;
    }
    for (;;) {
        const bool has_next = S.next(ui + 1, nxt);
        const char* nA = has_next ? (const char*)g.A + (size_t)nxt.pm * tstep : cA; const char* nB = has_next ? (const char*)g.Bt + (size_t)nxt.pn * tstep : cB;
        for (int t = 0; t < nt; t += 2) {
            const bool last = (t == nt - 2); const int zb = (2 * t >= nt) ? 1 : 0;
            const char* a1 = cA + (size_t)(t + 1) * kstep;
            const char* a2 = last ? nA : cA + (size_t)(t + 2) * kstep; const char* b2 = last ? nB : cB + (size_t)(t + 2) * kstep;
            const char* a3 = a2 + kstep; const char* b3 = b2 + kstep;
            if (last && has_next) S.a_ready(nxt);
            if constexpr (SP2) {
            PG8_LDB(B0, 0, 0); PG8_LDB(B1, 0, 1); PG8_SCHED; PG8_LDA(At, 0, 0); PG8_STAGE(PG8_SA(1, 1), a1 + hstep, voffA);
            PG8_WAIT_V(8); PG8_WAIT_L(0); PG8_BAR; PG8_MMA(0, 0, At, B0); if constexpr (!ZSKIP) PG8_MMA(0, 1, At, B1); PG8_BAR; PG8_SCHED;
            PG8_LDA(At, 0, 1); PG8_STAGE(PG8_SB(0, 0), b2, voffB); PG8_STAGE(PG8_SB(0, 1), b2 + hstep, voffB); PG8_STAGE(PG8_SA(0, 0), a2, voffA);
            PG8_WAIT_V(8); PG8_WAIT_L(0); PG8_BAR; PG8_MMA(1, 0, At, B0); if constexpr (!ZSKIP) PG8_MMA(1, 1, At, B1); PG8_BAR; PG8_SCHED;
            PG8_LDB(B0, 1, 0); PG8_LDB(B1, 1, 1); PG8_SCHED; PG8_LDA(At, 1, 0); PG8_STAGE(PG8_SA(0, 1), a2 + hstep, voffA);
            PG8_WAIT_V(8); PG8_WAIT_L(0); PG8_BAR; if constexpr (!ZSKIP) PG8_MMA(0, 0, At, B0); PG8_MMA(0, 1, At, B1); PG8_BAR; PG8_SCHED;
            PG8_LDA(At, 1, 1); PG8_STAGE(PG8_SB(1, 0), b3, voffB); PG8_STAGE(PG8_SB(1, 1), b3 + hstep, voffB); PG8_STAGE(PG8_SA(1, 0), a3, voffA);
            PG8_WAIT_V(8); PG8_WAIT_L(0); PG8_BAR; if constexpr (!ZSKIP) PG8_MMA(1, 0, At, B0); PG8_MMA(1, 1, At, B1); PG8_BAR; PG8_SCHED;
            } else {
            PG8_LDB(B0, 0, 0); PG8_SCHED; PG8_LDA(At, 0, 0); PG8_STAGE(PG8_SA(1, 1), a1 + hstep, voffA);
            PG8_WAIT_L(8); PG8_BAR; PG8_WAIT_L(0); PG8_MMA(0, 0, At, B0); PG8_BAR; PG8_SCHED;
            PG8_LDB(B1, 0, 1); PG8_STAGE(PG8_SB(0, 0), b2, voffB);
            PG8_BAR; PG8_WAIT_L(0); PG8_MMA(0, 1, At, B1); PG8_BAR;
            PG8_LDA(At, 0, 1); PG8_STAGE(PG8_SA(0, 0), a2, voffA);
            PG8_BAR; PG8_WAIT_L(0); PG8_MMA(1, 0, At, B0); PG8_BAR; PG8_SCHED;
            PG8_STAGE(PG8_SB(0, 1), b2 + hstep, voffB);
            PG8_WAIT_V(6); PG8_BAR; PG8_MMA(1, 1, At, B1); PG8_BAR;
            PG8_LDB(B0, 1, 0); PG8_SCHED; PG8_LDA(At, 1, 0); PG8_STAGE(PG8_SA(0, 1), a2 + hstep, voffA);
            PG8_WAIT_L(8); PG8_BAR; PG8_WAIT_L(0); PG8_MMA(0, 0, At, B0); PG8_BAR; PG8_SCHED;
            PG8_LDB(B1, 1, 1); PG8_STAGE(PG8_SB(1, 0), b3, voffB);
            PG8_BAR; PG8_WAIT_L(0); PG8_MMA(0, 1, At, B1); PG8_BAR;
            PG8_LDA(At, 1, 1); PG8_STAGE(PG8_SA(1, 0), a3, voffA);
            PG8_BAR; PG8_WAIT_L(0); PG8_MMA(1, 0, At, B0); PG8_BAR; PG8_SCHED;
            PG8_STAGE(PG8_SB(1, 1), b3 + hstep, voffB);
            PG8_WAIT_V(6); PG8_BAR; PG8_MMA(1, 1, At, B1); PG8_BAR;
            }
        }
        if constexpr (ALIGN_EPI) { if (wr == 0) PG8_BAR; }
        E(acc, cur, wr, wc, fr, fq); S.done(cur);
        if (!has_next) break;
#pragma unroll
        for (int a = 0; a < 2; ++a)
#pragma unroll
            for (int b = 0; b < 2; ++b)
#pragma unroll
                for (int m = 0; m < 4; ++m)
#pragma unroll
                    for (int n = 0; n < 2; ++n) acc[a][b][m][n] = (f32x4){0.f, 0.f, 0.f, 0.f};
        cur = nxt; cA = nA; cB = nB; ++ui;
        if constexpr (ALIGN_EPI) { if (wr == 1) PG8_BAR; }
    }
    PG8_WAIT_V(0);
    if constexpr (!ALIGN_EPI) { if (wr == 0) PG8_BAR; }
    PG8_BAR;
#undef PG8_SA
#undef PG8_SB
#undef PG8_STAGE
#undef PG8_LDA
#undef PG8_LDB
#undef PG8_MMA
#undef PG8_WAIT_V
#undef PG8_WAIT_L
#undef PG8_BAR
#undef PG8_SCHED
}
}

constexpr int T_TOK = 32768, DM = 1024, SEQ = 4096, NBATCH = 8, DIN = 5124, ZP = 5120, DFF = 2816, NMODC = 6144;
constexpr int GP = 2048;
constexpr size_t HM_A = (size_t)8 * 12 * 4096 * 64, HM_B = (size_t)8 * 4 * 4096 * 64;
constexpr size_t ZO_G = 0, ZO_QA = (size_t)T_TOK * GP, ZO_KA = ZO_QA + HM_A, ZO_VA = ZO_KA + HM_A, ZO_QB = ZO_VA + HM_A, ZO_KB = ZO_QB + HM_B, ZO_VB = ZO_KB + HM_B;
constexpr float LOG2E = 1.4426950408889634f;
constexpr float C2 = 0.125f * LOG2E;
constexpr size_t MiB = 1u << 20;
constexpr size_t WS_MOD = 0, WS_LOGF = 512 * 1024, WS_F2 = 1 * MiB, WS_CTL = 1536 * 1024, CTL_BYTES = 16384, WS_W = 2 * MiB, W_LAYER = 32 * MiB;
constexpr size_t WO_IN = 0, WO_OUT = 11534336, WO_FFI = 13631488, WO_FFO = 25165824, WO_UP = 30932992;
constexpr size_t WS_H = 66 * MiB, WS_Y = 130 * MiB, WS_Z = 162 * MiB, WS_END = 482 * MiB;
constexpr int LDS_RING = 131072, LDS_MISC = LDS_RING, LDS_BYTES = LDS_RING + 1024;
constexpr int NPHASE = 18;

typedef const f32x4 (&AccRef)[2][2][4][2];
__device__ __forceinline__ void epi_z(AccRef acc, const pg8::Unit& u, int wr, int wc, int fr, int fq, bf16_t* Z) {
    const int pn = u.pn; const int row0 = u.pm * 256 + wr * 64 + fr;
    if (pn >= 12) {
        const int col0 = (pn - 12) * 256 + wc * 32 + 8 * fq;
#pragma unroll
        for (int ai = 0; ai < 2; ++ai)
#pragma unroll
            for (int m = 0; m < 4; ++m) { bf16_t* rowp = Z + ZO_G + (size_t)(row0 + ai * 128 + m * 16) * GP + col0;
#pragma unroll
                for (int bj = 0; bj < 2; ++bj) { f32x4 v0 = acc[ai][bj][m][0], v1 = acc[ai][bj][m][1];
#pragma unroll
                    for (int e = 0; e < 4; ++e) { v0[e] = sigmoidf_fast(v0[e]); v1[e] = sigmoidf_fast(v1[e]); }
                    u32x4 w; w.x = cvtpk(v0[0], v0[1]); w.y = cvtpk(v0[2], v0[3]); w.z = cvtpk(v1[0], v1[1]); w.w = cvtpk(v1[2], v1[3]);
                    *(u32x4*)(rowp + bj * 128) = w; } }
        return;
    }
    const bool isA = pn < 9; const int sec = isA ? pn / 3 : pn - 9, g = isA ? pn % 3 : 0, sh = 2 * g;
    const float sc = (sec == 0) ? C2 : 1.0f;
    bf16_t* base = Z + (isA ? ZO_QA + (size_t)sec * HM_A : ZO_QB + (size_t)sec * HM_B);
    const int b = u.pm >> 4, nh = isA ? 12 : 4;
    const int dc = ((wc & 1) * 32 + 8 * fq);
#pragma unroll
    for (int ai = 0; ai < 2; ++ai)
#pragma unroll
        for (int m = 0; m < 4; ++m) { const int srow = (row0 + ai * 128 + m * 16) & (SEQ - 1);
            const int pos = ((srow & ((1 << sh) - 1)) << (12 - sh)) + (srow >> sh);
#pragma unroll
            for (int bj = 0; bj < 2; ++bj) { const int head = g * 4 + bj * 2 + (wc >> 1);
                f32x4 v0 = acc[ai][bj][m][0] * sc, v1 = acc[ai][bj][m][1] * sc;
                u32x4 w; w.x = cvtpk(v0[0], v0[1]); w.y = cvtpk(v0[2], v0[3]); w.z = cvtpk(v1[0], v1[1]); w.w = cvtpk(v1[2], v1[3]);
                *(u32x4*)(base + ((size_t)(b * nh + head) * SEQ + pos) * 64 + dc) = w; } }
}
__device__ __forceinline__ void epi_up(AccRef acc, const pg8::Unit& u, int wr, int wc, int fr, int fq, const bf16_t* G, bf16_t* O) {
    const int row0 = u.pm * 256 + wr * 64 + fr, col0 = u.pn * 128 + wc * 32 + 8 * fq;
#pragma unroll
    for (int ai = 0; ai < 2; ++ai) {
        u32x4 ga[4], gb[4];
#pragma unroll
        for (int m = 0; m < 4; ++m) { const size_t row = (size_t)(row0 + ai * 128 + m * 16); ga[m] = *(const u32x4*)(G + row * GP + col0); gb[m] = *(const u32x4*)(G + row * GP + 1024 + col0); }
#pragma unroll
        for (int m = 0; m < 4; ++m) { const size_t row = (size_t)(row0 + ai * 128 + m * 16);
            const f32x4 a0 = acc[ai][0][m][0], a1 = acc[ai][0][m][1], b0 = acc[ai][1][m][0], b1 = acc[ai][1][m][1]; f32x4 v0, v1;
            v0[0] = a0[0] * bf_lo(ga[m].x) + b0[0] * bf_lo(gb[m].x); v0[1] = a0[1] * bf_hi(ga[m].x) + b0[1] * bf_hi(gb[m].x); v0[2] = a0[2] * bf_lo(ga[m].y) + b0[2] * bf_lo(gb[m].y); v0[3] = a0[3] * bf_hi(ga[m].y) + b0[3] * bf_hi(gb[m].y);
            v1[0] = a1[0] * bf_lo(ga[m].z) + b1[0] * bf_lo(gb[m].z); v1[1] = a1[1] * bf_hi(ga[m].z) + b1[1] * bf_hi(gb[m].z); v1[2] = a1[2] * bf_lo(ga[m].w) + b1[2] * bf_lo(gb[m].w); v1[3] = a1[3] * bf_hi(ga[m].w) + b1[3] * bf_hi(gb[m].w);
            u32x4 w; w.x = cvtpk(v0[0], v0[1]); w.y = cvtpk(v0[2], v0[3]); w.z = cvtpk(v1[0], v1[1]); w.w = cvtpk(v1[2], v1[3]);
            *(u32x4*)(O + row * DM + col0) = w; }
        asm volatile("" ::: "memory"); }
}
__device__ __forceinline__ void epi_res(AccRef acc, const pg8::Unit& u, int wr, int wc, int fr, int fq, const float* xin, float* xout, const float* g) {
    const float* gb = g + (size_t)(u.pm >> 4) * NMODC; const int col0 = u.pn * 256 + wc * 32 + 8 * fq;
    f32x4 gv[2][2];
#pragma unroll
    for (int bj = 0; bj < 2; ++bj)
#pragma unroll
        for (int n = 0; n < 2; ++n) gv[bj][n] = *(const f32x4*)(gb + col0 + bj * 128 + n * 4);
#pragma unroll
    for (int ai = 0; ai < 2; ++ai) {
        f32x4 xv[4][2][2];
#pragma unroll
        for (int m = 0; m < 4; ++m) { const size_t off = (size_t)(u.pm * 256 + ai * 128 + wr * 64 + m * 16 + fr) * DM + col0;
#pragma unroll
            for (int bj = 0; bj < 2; ++bj)
#pragma unroll
                for (int n = 0; n < 2; ++n) xv[m][bj][n] = *(const f32x4*)(xin + off + bj * 128 + n * 4); }
#pragma unroll
        for (int m = 0; m < 4; ++m) { const size_t off = (size_t)(u.pm * 256 + ai * 128 + wr * 64 + m * 16 + fr) * DM + col0;
#pragma unroll
            for (int bj = 0; bj < 2; ++bj)
#pragma unroll
                for (int n = 0; n < 2; ++n) *(f32x4*)(xout + off + bj * 128 + n * 4) = xv[m][bj][n] + gv[bj][n] * acc[ai][bj][m][n]; }
        asm volatile("" ::: "memory"); }
}
__device__ __forceinline__ void epi_swi(AccRef acc, const pg8::Unit& u, int wr, int wc, int fr, int fq, bf16_t* O) {
    const int row0 = u.pm * 256 + wr * 64 + fr, col0 = u.pn * 128 + wc * 32 + 8 * fq;
#pragma unroll
    for (int ai = 0; ai < 2; ++ai)
#pragma unroll
        for (int m = 0; m < 4; ++m) { f32x4 h0, h1;
#pragma unroll
            for (int e = 0; e < 4; ++e) { const float g0 = acc[ai][0][m][0][e], g1 = acc[ai][0][m][1][e];
                h0[e] = g0 * sigmoidf_fast(g0) * acc[ai][1][m][0][e]; h1[e] = g1 * sigmoidf_fast(g1) * acc[ai][1][m][1][e]; }
            u32x4 w; w.x = cvtpk(h0[0], h0[1]); w.y = cvtpk(h0[2], h0[3]); w.z = cvtpk(h1[0], h1[1]); w.w = cvtpk(h1[2], h1[3]);
            *(u32x4*)(O + (size_t)(row0 + ai * 128 + m * 16) * DFF + col0) = w; }
}
struct EpiUpOnly {
    static constexpr bool PERM = true;
    const bf16_t* G; bf16_t* O;
    __device__ __forceinline__ void operator()(AccRef acc, const pg8::Unit& u, int wr, int wc, int fr, int fq) const { epi_up(acc, u, wr, wc, fr, fq, G, O); }
};
struct EpiAny {
    static constexpr bool PERM = true;
    int mode; const void* src; void* dst; const float* g;
    __device__ __forceinline__ void operator()(AccRef acc, const pg8::Unit& u, int wr, int wc, int fr, int fq) const {
        switch (mode) {
        case 0: epi_z(acc, u, wr, wc, fr, fq, (bf16_t*)dst); break;
        case 3: epi_res(acc, u, wr, wc, fr, fq, (const float*)src, (float*)dst, g); break;
        default: epi_swi(acc, u, wr, wc, fr, fq, (bf16_t*)dst); break;
        }
    }
};

__device__ __forceinline__ float lane_xor(float v, int o, int lane) { return __int_as_float(__builtin_amdgcn_ds_bpermute((lane ^ o) << 2, __float_as_int(v))); }
__device__ __forceinline__ float wave_sum(float v, int lane) {
#pragma unroll
    for (int o = 1; o < 64; o <<= 1) v += lane_xor(v, o, lane);
    return v;
}
__device__ __forceinline__ int crow(int r, int hi) { return (r & 3) + 8 * (r >> 2) + 4 * hi; }

__device__ __forceinline__ void zero_item(bf16_t* WT, int K, int dstrow, int k0, int lane) {
    const int c = lane & 7;
#pragma unroll
    for (int j = 0; j < 4; ++j) { const int n = (lane >> 3) + 8 * j; *(u32x4*)(WT + (size_t)(dstrow + n) * K + k0 + 8 * c) = (u32x4){0u, 0u, 0u, 0u}; }
}
__device__ __forceinline__ void transpose_item(const float* W, int ldw, int srccol, bf16_t* WT, int K, int dstrow, int k0, LAS float* scr, int lane, int srck0 = -1) {
    if (srck0 < 0) srck0 = k0;
    float tv[32];
#pragma unroll
    for (int i = 0; i < 32; ++i) tv[i] = W[(size_t)(srck0 + 2 * i + (lane >> 5)) * ldw + srccol + (lane & 31)];
#pragma unroll
    for (int i = 0; i < 32; ++i) scr[(2 * i + (lane >> 5)) * 33 + (lane & 31)] = tv[i];
    asm volatile("s_waitcnt lgkmcnt(0)" ::: "memory");
    const int c = lane & 7;
#pragma unroll
    for (int j = 0; j < 4; ++j) { const int n = (lane >> 3) + 8 * j; const LAS float* s = scr + (8 * c) * 33 + n;
        u32x4 o; o.x = cvtpk(s[0 * 33], s[1 * 33]); o.y = cvtpk(s[2 * 33], s[3 * 33]); o.z = cvtpk(s[4 * 33], s[5 * 33]); o.w = cvtpk(s[6 * 33], s[7 * 33]);
        *(u32x4*)(WT + (size_t)(dstrow + n) * K + k0 + 8 * c) = o; }
    asm volatile("s_waitcnt lgkmcnt(0)" ::: "memory");
}

struct Args { const float* in[14]; float* out; unsigned char* ws; int ph_lo, ph_hi; };
typedef const __attribute__((address_space(4))) Args* KArgs;

__device__ __forceinline__ void phase_prologue(KArgs a, LAS unsigned char* lds, int tid, int lane, int wid) {
    const float* c = a->in[1]; const float* w_ada = a->in[2]; const float* b_ada = a->in[3];
    float* mod = (float*)(a->ws + WS_MOD);
    for (int cgp = blockIdx.x; cgp < 48; cgp += gridDim.x) {
        LAS float* cact = (LAS float*)lds;
        LAS float* red = (LAS float*)(lds + 32768);
        for (int i = tid; i < 8192; i += 512) { const int b = i >> 10, k = i & 1023; const float v = c[i]; cact[k * 8 + b] = v * sigmoidf_fast(v); }
        __syncthreads();
        const int l = cgp / 24, col0 = (cgp % 24) * 256;
        float acc[8][4];
#pragma unroll
        for (int b = 0; b < 8; ++b)
#pragma unroll
            for (int e = 0; e < 4; ++e) acc[b][e] = 0.f;
        const float* wp = w_ada + ((size_t)l * DM + wid * 128) * NMODC + col0 + 4 * lane;
#pragma unroll 16
        for (int k = 0; k < 128; ++k) {
            const f32x4 wv = *(const f32x4*)(wp + (size_t)k * NMODC);
            const f32x4 c0 = *(const LAS f32x4*)(cact + (wid * 128 + k) * 8), c1 = *(const LAS f32x4*)(cact + (wid * 128 + k) * 8 + 4);
#pragma unroll
            for (int e = 0; e < 4; ++e) { acc[0][e] += c0[0] * wv[e]; acc[1][e] += c0[1] * wv[e]; acc[2][e] += c0[2] * wv[e]; acc[3][e] += c0[3] * wv[e];
                                          acc[4][e] += c1[0] * wv[e]; acc[5][e] += c1[1] * wv[e]; acc[6][e] += c1[2] * wv[e]; acc[7][e] += c1[3] * wv[e]; }
        }
#pragma unroll
        for (int b = 0; b < 8; ++b)
#pragma unroll
            for (int e = 0; e < 4; ++e) red[(wid * 32 + b * 4 + e) * 64 + lane] = acc[b][e];
        __syncthreads();
#pragma unroll
        for (int i = 0; i < 4; ++i) { const int o = tid + 512 * i, b = o >> 8, cl = o & 255, ln = cl >> 2, e = cl & 3;
            float s = b_ada[(size_t)l * NMODC + col0 + cl];
#pragma unroll
            for (int w = 0; w < 8; ++w) s += red[(w * 32 + b * 4 + e) * 64 + ln];
            mod[((size_t)l * 8 + b) * NMODC + col0 + cl] = s; }
        __syncthreads();
    }
    LAS float* scr = (LAS float*)(lds + wid * 8448);
    const int gw = blockIdx.x * 8 + wid, NGW = gridDim.x * 8;
    constexpr int I_IN = 160 * 16, I_UP = 64 * 8, I_OUT = 32 * 16, I_FFI = 176 * 16, I_FFO = 32 * 44, I_LAYER = I_IN + I_UP + I_OUT + I_FFI + I_FFO;
    for (int it = gw; it < 2 * I_LAYER; it += NGW) {
        const int l = it / I_LAYER; int r = it % I_LAYER;
        unsigned char* wl = a->ws + WS_W + (size_t)l * W_LAYER;
        if (r < I_IN) { const int nb = r % 160, kb = r / 160, dr = nb * 32; transpose_item(a->in[5] + (size_t)l * DM * DIN, DIN, dr < 3072 ? dr : dr + 4, (bf16_t*)(wl + WO_IN), DM, dr, kb * 64, scr, lane); continue; } r -= I_IN;
        if (r < I_UP) {
            const int nb = r % 64, kb = r / 64, dr = nb * 32, pn = dr >> 8, w = dr & 255, br = w >> 7, ch = pn * 128 + (w & 127);
            if ((kb & 1) == br) transpose_item(a->in[br ? 8 : 7] + (size_t)l * 256 * DM, DM, ch, (bf16_t*)(wl + WO_UP), 512, dr, kb * 64, scr, lane, (kb >> 1) * 64);
            else zero_item((bf16_t*)(wl + WO_UP), 512, dr, kb * 64, lane);
            continue; } r -= I_UP;
        if (r < I_OUT) { const int nb = r % 32, kb = r / 32; transpose_item(a->in[9] + (size_t)l * DM * DM, DM, nb * 32, (bf16_t*)(wl + WO_OUT), DM, nb * 32, kb * 64, scr, lane); continue; } r -= I_OUT;
        if (r < I_FFI) { const int nb = r % 176, kb = r / 176, dr = nb * 32, pn = dr >> 8, wi = dr & 255; const int sc = wi < 128 ? pn * 128 + wi : DFF + pn * 128 + (wi - 128);
            transpose_item(a->in[11] + (size_t)l * DM * 2 * DFF, 2 * DFF, sc, (bf16_t*)(wl + WO_FFI), DM, dr, kb * 64, scr, lane); continue; } r -= I_FFI;
        { const int nb = r % 32, kb = r / 32; transpose_item(a->in[12] + (size_t)l * DFF * DM, DM, nb * 32, (bf16_t*)(wl + WO_FFO), DFF, nb * 32, kb * 64, scr, lane); }
    }
}

template <int SUB>
__device__ __forceinline__ void phase_norm(KArgs a, int l, LAS unsigned char* lds, int tid, int lane, int wid) {
    const float* xin = (SUB == 1 && l == 0) ? a->in[0] : a->out;
    const float* mod = (const float*)(a->ws + WS_MOD);
    bf16_t* H = (bf16_t*)(a->ws + WS_H);
    float* logf_out = (float*)(a->ws + WS_LOGF);
    LAS f32x4* Al = (LAS f32x4*)lds; LAS f32x4* Bl = (LAS f32x4*)(lds + 4096);
    for (int rb = blockIdx.x; rb < T_TOK / 128; rb += gridDim.x) {
        const int b = rb >> 5;
        const size_t rbase = (size_t)rb * 128 + wid * 16;
        constexpr int NPRE = (SUB == 1) ? 3 : 2;
        f32x4 vn[NPRE][4];
#pragma unroll
        for (int p = 0; p < NPRE; ++p)
#pragma unroll
            for (int j = 0; j < 4; ++j) vn[p][j] = *((const f32x4*)(xin + (rbase + p) * DM) + lane + 64 * j);
        __syncthreads();
        for (int i = tid; i < DM; i += 512) {
            float av, bv;
            if (SUB == 3) { av = a->in[13][i]; bv = 0.f; }
            else { const float* mb = mod + ((size_t)l * 8 + b) * NMODC; const float nw = (SUB == 1 ? a->in[4] : a->in[10])[l * DM + i];
                   av = nw * (1.0f + mb[(SUB == 1 ? 1 : 4) * DM + i]); bv = mb[(SUB == 1 ? 0 : 3) * DM + i]; }
            ((LAS float*)Al)[i] = av; ((LAS float*)Bl)[i] = bv;
        }
        __syncthreads();
        f32x4 wf[16]; float bfv[4] = {0.f, 0.f, 0.f, 0.f};
        if (SUB == 1) {
            const float* wfp = a->in[5] + (size_t)l * DM * DIN + 3072;
#pragma unroll
            for (int j = 0; j < 4; ++j)
#pragma unroll
                for (int e = 0; e < 4; ++e) wf[j * 4 + e] = *(const f32x4*)(wfp + (size_t)(4 * lane + 256 * j + e) * DIN);
#pragma unroll
            for (int n = 0; n < 4; ++n) bfv[n] = a->in[6][l * 4 + n];
        }
        auto do_row = [&](const f32x4 (&v)[4], const size_t row) __attribute__((always_inline)) {
            float ss = 0.f;
#pragma unroll
            for (int j = 0; j < 4; ++j) ss += (v[j].x * v[j].x + v[j].y * v[j].y) + (v[j].z * v[j].z + v[j].w * v[j].w);
            const float rstd = 1.0f / sqrtf(wave_sum(ss, lane) * (1.0f / DM) + 1e-6f);
            float fz[4] = {0.f, 0.f, 0.f, 0.f};
#pragma unroll
            for (int j = 0; j < 4; ++j) {
                const f32x4 hv = v[j] * rstd * Al[lane + 64 * j] + Bl[lane + 64 * j];
                if (SUB == 3) { *((f32x4*)(a->out + row * DM) + lane + 64 * j) = hv; }
                else { u32x2 w; w.x = cvtpk(hv[0], hv[1]); w.y = cvtpk(hv[2], hv[3]); *(u32x2*)(H + row * DM + 4 * lane + 256 * j) = w; }
                if (SUB == 1) {
#pragma unroll
                    for (int e = 0; e < 4; ++e)
#pragma unroll
                        for (int n = 0; n < 4; ++n) fz[n] += hv[e] * wf[j * 4 + e][n];
                }
            }
            if (SUB == 1) {
                f32x4 lf;
#pragma unroll
                for (int n = 0; n < 4; ++n) { const float y = wave_sum(fz[n], lane) + bfv[n];
                    const float e_ = __builtin_amdgcn_exp2f(-LOG2E * fabsf(y));
                    lf[n] = fminf(y, 0.f) - (e_ < 1e-3f ? e_ * (1.0f - 0.5f * e_) : 0.69314718056f * __builtin_amdgcn_logf(1.0f + e_)); }
                if (lane == 0) *(f32x4*)(logf_out + row * 4) = lf;
            }
        };
        if constexpr (SUB == 1) {
            constexpr int PD = 3;
#pragma unroll
            for (int i = 0; i < 16; ++i) {
                f32x4 v[4];
#pragma unroll
                for (int j = 0; j < 4; ++j) v[j] = vn[i % PD][j];
                if (i + PD < 16) {
#pragma unroll
                    for (int j = 0; j < 4; ++j) vn[i % PD][j] = *((const f32x4*)(xin + (rbase + i + PD) * DM) + lane + 64 * j); }
                do_row(v, rbase + i);
            }
        } else {
            for (int i = 0; i < 16; i += 2) {
                f32x4 v[2][4];
#pragma unroll
                for (int q = 0; q < 2; ++q)
#pragma unroll
                    for (int j = 0; j < 4; ++j) v[q][j] = vn[q][j];
                if (i + 2 < 16) {
#pragma unroll
                    for (int q = 0; q < 2; ++q)
#pragma unroll
                        for (int j = 0; j < 4; ++j) vn[q][j] = *((const f32x4*)(xin + (rbase + i + 2 + q) * DM) + lane + 64 * j); }
                do_row(v[0], rbase + i); do_row(v[1], rbase + i + 1);
            }
        }
    }
}

__device__ __forceinline__ void phase_scan(KArgs a, LAS unsigned char* lds, int tid, int lane, int wid) {
    const float* logf_in = (const float*)(a->ws + WS_LOGF); float* F2 = (float*)(a->ws + WS_F2);
    LAS float* wt = (LAS float*)(lds + LDS_MISC);
    for (int bh = blockIdx.x; bh < 32; bh += gridDim.x) {
        const int b = bh >> 2, h = bh & 3;
        float v[8]; float run = 0.f;
#pragma unroll
        for (int i = 0; i < 8; ++i) { run += logf_in[((size_t)b * SEQ + 8 * tid + i) * 4 + h]; v[i] = run; }
        float incl = run;
#pragma unroll
        for (int o = 1; o < 64; o <<= 1) { const float t = __int_as_float(__builtin_amdgcn_ds_bpermute(((lane - o) & 63) << 2, __float_as_int(incl))); if (lane >= o) incl += t; }
        __syncthreads();
        if (lane == 63) wt[wid] = incl;
        __syncthreads();
        float off = incl - run;
        for (int w = 0; w < wid; ++w) off += wt[w];
#pragma unroll
        for (int i = 0; i < 8; ++i) F2[(size_t)bh * SEQ + 8 * tid + i] = (v[i] + off) * LOG2E;
    }
    __syncthreads();
}

typedef short v4i16_t __attribute__((ext_vector_type(4)));
__device__ __forceinline__ s16x4 vtr(const LAS unsigned char* p) { return __builtin_bit_cast(s16x4, __builtin_amdgcn_ds_read_tr16_b64_v4i16((LAS v4i16_t*)p)); }
__device__ __forceinline__ float hmax2(float m) { auto rr = __builtin_amdgcn_permlane32_swap(__float_as_uint(m), __float_as_uint(m), false, false); return fmaxf(__uint_as_float(rr[0]), __uint_as_float(rr[1])); }
__device__ __forceinline__ float hsum2(float m) { auto rr = __builtin_amdgcn_permlane32_swap(__float_as_uint(m), __float_as_uint(m), false, false); return __uint_as_float(rr[0]) + __uint_as_float(rr[1]); }

#define ATT_THR 3.0f
template <int NS>
__device__ __forceinline__ void attn_qk(const bf16x8 (&kf)[NS][4], const bf16x8 (&qr)[4], f32x16 (&s)[NS]) {
#pragma unroll
    for (int d0 = 0; d0 < 4; ++d0)
#pragma unroll
        for (int i = 0; i < NS; ++i) s[i] = __builtin_amdgcn_mfma_f32_32x32x16_bf16(kf[i][d0], qr[d0], s[i], 0, 0, 0);
}
template <int NS>
__device__ __forceinline__ void attn_sm(f32x16 (&s)[NS], const LAS unsigned char* vb, int vhalf, bool first, float& m, float& l, f32x16& o0, f32x16& o1) {
    float rm = fmaxf(s[0][0], s[0][1]), rm2 = fmaxf(s[0][2], s[0][3]);
#pragma unroll
    for (int i = 0; i < NS; ++i)
#pragma unroll
        for (int r = (i == 0 ? 4 : 0); r < 16; r += 4) { rm = __builtin_fmaxf(__builtin_fmaxf(rm, s[i][r]), s[i][r + 1]); rm2 = __builtin_fmaxf(__builtin_fmaxf(rm2, s[i][r + 2]), s[i][r + 3]); }
    rm = fmaxf(rm, rm2);
    rm = hmax2(rm);
    if (first || __any(rm > ATT_THR)) {
        const float delta = first ? rm : fmaxf(rm, 0.f);
        m += delta;
        const float f = __builtin_amdgcn_exp2f(-delta);
        l *= f; o0 = o0 * f; o1 = o1 * f;
#pragma unroll
        for (int i = 0; i < NS; ++i) s[i] = s[i] - delta;
    }
    float ps = 0.f;
#pragma unroll
    for (int i = 0; i < NS; ++i)
#pragma unroll
        for (int r = 0; r < 16; ++r) { s[i][r] = __builtin_amdgcn_exp2f(s[i][r]); ps += s[i][r]; }
    l += ps;
#pragma unroll
    for (int i = 0; i < NS; ++i) {
        u32x4 p0 = {cvtpk(s[i][0], s[i][1]), cvtpk(s[i][2], s[i][3]), cvtpk(s[i][4], s[i][5]), cvtpk(s[i][6], s[i][7])};
        u32x4 p1 = {cvtpk(s[i][8], s[i][9]), cvtpk(s[i][10], s[i][11]), cvtpk(s[i][12], s[i][13]), cvtpk(s[i][14], s[i][15])};
        const bf16x8 pb0 = __builtin_bit_cast(bf16x8, p0), pb1 = __builtin_bit_cast(bf16x8, p1);
#pragma unroll
        for (int st = 0; st < 2; ++st) {
            const LAS unsigned char* vp = vb + i * 2048 + st * 1024;
            const s16x4 a0 = vtr(vp), a1 = vtr(vp + 512), b0 = vtr(vp + vhalf), b1 = vtr(vp + vhalf + 512);
            const bf16x8 vf0 = {a0[0], a0[1], a0[2], a0[3], a1[0], a1[1], a1[2], a1[3]}, vf1 = {b0[0], b0[1], b0[2], b0[3], b1[0], b1[1], b1[2], b1[3]};
            o0 = __builtin_amdgcn_mfma_f32_32x32x16_bf16(vf0, st ? pb1 : pb0, o0, 0, 0, 0);
            o1 = __builtin_amdgcn_mfma_f32_32x32x16_bf16(vf1, st ? pb1 : pb0, o1, 0, 0, 0);
        }
    }
}

__device__ __forceinline__ void fox_unit(KArgs a, LAS unsigned char* lds, int b, int h, int qb, int tid, int lane, int wid) {
    const bf16_t* Z = (const bf16_t*)(a->ws + WS_Z); const float* F2 = (const float*)(a->ws + WS_F2) + (size_t)(b * 4 + h) * SEQ; bf16_t* YB = (bf16_t*)(a->ws + WS_Y) + 64;
    const int r32 = lane & 31, hi = lane >> 5;
    constexpr int FB = 17664;
    const int qrow = qb * 256 + wid * 32 + r32; const size_t tok = (size_t)b * SEQ + qrow;
    bf16x8 qr[4];
#pragma unroll
    for (int d0 = 0; d0 < 4; ++d0) qr[d0] = *(const bf16x8*)(Z + ZO_QB + ((size_t)(b * 4 + h) * SEQ + qrow) * 64 + d0 * 16 + hi * 8);
    const float Fq = F2[qrow];
    const int wfirst = qb * 256 + wid * 32, wlast = wfirst + 31;
    const int NT = (qb + 1) * 4;
    const int lkey = tid >> 3, lch = tid & 7;
    const bf16_t* ksrc = Z + ZO_KB + ((size_t)(b * 4 + h) * SEQ + lkey) * 64 + lch * 8;
    const bf16_t* vsrc = Z + ZO_VB + ((size_t)(b * 4 + h) * SEQ + lkey) * 64 + lch * 8;
    u32x4 kr0 = *(const u32x4*)(ksrc + (size_t)(NT - 1) * 64 * 64), vr0 = *(const u32x4*)(vsrc + (size_t)(NT - 1) * 64 * 64); float fr0 = (tid < 64) ? F2[(NT - 1) * 64 + tid] : 0.f;
    u32x4 kr1 = *(const u32x4*)(ksrc + (size_t)(NT - 2) * 64 * 64), vr1 = *(const u32x4*)(vsrc + (size_t)(NT - 2) * 64 * 64); float fr1 = (tid < 64) ? F2[(NT - 2) * 64 + tid] : 0.f;
    float m = 0.f, l = 0.f, fqm = Fq; f32x16 o0 = {}, o1 = {}; bool first = true;
    const int vlane = (4 * hi + ((lane & 15) >> 2)) * 64 + ((lane >> 4) & 1) * 32 + (lane & 3) * 8;
    __syncthreads();
    *(LAS u32x4*)(lds + lkey * 144 + lch * 16) = kr0;
    *(LAS u32x4*)(lds + 9216 + (lch >> 2) * 4096 + lkey * 64 + (lch & 3) * 16) = vr0;
    if (tid < 64) *(LAS float*)(lds + 17408 + tid * 4) = fr0;
    __syncthreads();
#define FOX_STEP(it_, KN, VN, FN, KW, VW, FW) do { const int it = (it_); const int t = NT - 1 - it; LAS unsigned char* buf = lds + (it & 1) * FB; LAS unsigned char* nbuf = lds + ((it & 1) ^ 1) * FB; \
        if (it + 2 < NT) { KN = *(const u32x4*)(ksrc + (size_t)(t - 2) * 64 * 64); VN = *(const u32x4*)(vsrc + (size_t)(t - 2) * 64 * 64); if (tid < 64) FN = F2[(t - 2) * 64 + tid]; } \
        if (t * 64 <= wlast) { \
            bf16x8 kf[2][4]; f32x16 s[2]; \
            _Pragma("unroll") for (int kk = 0; kk < 2; ++kk) _Pragma("unroll") for (int d0 = 0; d0 < 4; ++d0) kf[kk][d0] = *(const LAS bf16x8*)(buf + (kk * 32 + r32) * 144 + d0 * 32 + hi * 16); \
            const LAS float* Ft = (const LAS float*)(buf + 17408); \
            _Pragma("unroll") for (int kk = 0; kk < 2; ++kk) _Pragma("unroll") for (int g = 0; g < 4; ++g) { const f32x4 fk = *(const LAS f32x4*)(Ft + kk * 32 + 8 * g + 4 * hi); \
                _Pragma("unroll") for (int e = 0; e < 4; ++e) s[kk][4 * g + e] = fqm - fk[e]; } \
            if (t * 64 + 63 > wfirst) { \
                _Pragma("unroll") for (int kk = 0; kk < 2; ++kk) _Pragma("unroll") for (int r = 0; r < 16; ++r) if (t * 64 + kk * 32 + crow(r, hi) > qrow) s[kk][r] = -INFINITY; } \
            attn_qk<2>(kf, qr, s); attn_sm<2>(s, buf + 9216 + vlane, 4096, first, m, l, o0, o1); \
            first = false; fqm = Fq - m; } \
        if (it + 1 < NT) { \
            *(LAS u32x4*)(nbuf + lkey * 144 + lch * 16) = KW; \
            *(LAS u32x4*)(nbuf + 9216 + (lch >> 2) * 4096 + lkey * 64 + (lch & 3) * 16) = VW; \
            if (tid < 64) *(LAS float*)(nbuf + 17408 + tid * 4) = FW; } \
        __syncthreads(); } while (0)
#pragma unroll 1
    for (int it2 = 0; it2 < NT; it2 += 2) {
        FOX_STEP(it2, kr0, vr0, fr0, kr1, vr1, fr1);
        FOX_STEP(it2 + 1, kr1, vr1, fr1, kr0, vr0, fr0);
    }
#undef FOX_STEP
    const float rl = 1.0f / hsum2(l);
    bf16_t* op = YB + tok * 512 + h * 128;
#pragma unroll
    for (int g = 0; g < 4; ++g) {
        u32x2 w0 = {cvtpk(o0[4 * g] * rl, o0[4 * g + 1] * rl), cvtpk(o0[4 * g + 2] * rl, o0[4 * g + 3] * rl)};
        u32x2 w1 = {cvtpk(o1[4 * g] * rl, o1[4 * g + 1] * rl), cvtpk(o1[4 * g + 2] * rl, o1[4 * g + 3] * rl)};
        *(u32x2*)(op + 8 * g + 4 * hi) = w0; *(u32x2*)(op + 32 + 8 * g + 4 * hi) = w1;
    }
}

__device__ __forceinline__ void dil_item(KArgs a, LAS unsigned char* lds, int item, int tid, int lane, int wid) {
    const bf16_t* Z = (const bf16_t*)(a->ws + WS_Z); bf16_t* YA = (bf16_t*)(a->ws + WS_Y);
    unsigned char* tmpb = a->ws + WS_H + (size_t)blockIdx.x * (3 * 512 * 64 * 2 + 3 * 512 * 4);
    bf16_t* TO = (bf16_t*)tmpb; float* TL = (float*)(tmpb + 3 * 512 * 64 * 2);
    const int b = item >> 5, slot = (item >> 3) & 3, s0 = (item & 7) * 512;
    const int r32 = lane & 31, hi = lane >> 5;
    LAS unsigned char* vbuf = lds + wid * 4096;
    const LAS unsigned char* vb0 = vbuf + (4 * hi + ((lane & 15) >> 2)) * 64 + ((lane >> 4) & 1) * 32 + (lane & 3) * 8;
    __syncthreads();
#pragma unroll 1
    for (int g = 0; g < 3; ++g) {
        const int sh = 2 * g, d = 1 << sh, head = 4 * g + slot;
        const float slope2 = exp2f(-8.0f * (float)(head + 1) / 12.0f) * (float)d * LOG2E;
#pragma unroll 1
        for (int j = 0; j < 2; ++j) {
            const int sub = wid * 2 + j, spc = 16 >> sh, cls = sub / spc, lsub = sub % spc;
            const int l0 = (s0 >> sh) + lsub * 32;
            const size_t hb = ((size_t)(b * 12 + head) * SEQ + (size_t)cls * (SEQ >> sh)) * 64;
            const int tl = (l0 + r32) * d + cls - s0;
            bf16x8 qr[4];
            { const bf16_t* qp = Z + ZO_QA + hb + (size_t)(l0 + r32) * 64 + hi * 8;
#pragma unroll
              for (int d0 = 0; d0 < 4; ++d0) qr[d0] = *(const bf16x8*)(qp + d0 * 16); }
            float m = 0.f, l = 0.f; f32x16 o0 = {}, o1 = {};
            const int cstart = (l0 >= 128) ? 0 : ((128 - l0) >> 5);
            bf16x8 kA[1][4], kB[1][4]; u32x4 vA[4], vB[4];
            const bf16_t* kbase = Z + ZO_KA + hb + (size_t)(l0 - 128 + r32) * 64 + hi * 8;
            const bf16_t* vbase = Z + ZO_VA + hb + (size_t)(l0 - 128 + (lane >> 3)) * 64 + (lane & 7) * 8;
            const float sl4 = slope2 * (float)(4 * hi);
#define DIL_LOADK(KF, c) do { if ((c) >= cstart) { _Pragma("unroll") for (int d0 = 0; d0 < 4; ++d0) KF[0][d0] = *(const bf16x8*)(kbase + (c) * 2048 + d0 * 16); } } while (0)
#define DIL_LOADV(VR, c) do { if ((c) >= cstart) { _Pragma("unroll") for (int i = 0; i < 4; ++i) VR[i] = *(const u32x4*)(vbase + (c) * 2048 + i * 512); } } while (0)
#define DIL_STEP(KF, VR, c) do { if ((c) >= cstart) { \
                _Pragma("unroll") for (int i = 0; i < 4; ++i) { const int idx = i * 64 + lane, kv = idx >> 3, ch = idx & 7; *(LAS u32x4*)(vbuf + (ch >> 2) * 2048 + kv * 64 + (ch & 3) * 16) = VR[i]; } \
                if ((c) >= 2) DIL_LOADV(VR, (c) - 2); \
                f32x16 s[1]; const float t1 = sl4 - slope2 * (float)(128 + r32 - 32 * (c)) - m;        \
                _Pragma("unroll") for (int r = 0; r < 16; ++r) { const int kc_ = (r & 3) + 8 * (r >> 2); float v_ = slope2 * (float)kc_ + t1; \
                    if ((c) == 4) { if (kc_ + 4 * hi > r32) v_ = -INFINITY; } \
                    if ((c) == 0) { if (kc_ + 4 * hi < r32) v_ = -INFINITY; } \
                    s[0][r] = v_; } \
                attn_qk<1>(KF, qr, s); \
                if ((c) >= 2) DIL_LOADK(KF, (c) - 2); \
                attn_sm<1>(s, vb0, 2048, (c) == 4, m, l, o0, o1); } } while (0)
            DIL_LOADK(kA, 4); DIL_LOADV(vA, 4); DIL_LOADK(kB, 3); DIL_LOADV(vB, 3);
            DIL_STEP(kA, vA, 4);
            DIL_STEP(kB, vB, 3);
            DIL_STEP(kA, vA, 2);
            DIL_STEP(kB, vB, 1);
            DIL_STEP(kA, vA, 0);
#undef DIL_STEP
#undef DIL_LOADK
#define DIL_LOAD DIL_LOADV
#undef DIL_LOAD
            l = hsum2(l);
            const float rl = 1.0f / l;
            bf16_t* op = TO + ((size_t)g * 512 + tl) * 64;
#pragma unroll
            for (int gg = 0; gg < 4; ++gg) {
                u32x2 w0 = {cvtpk(o0[4 * gg] * rl, o0[4 * gg + 1] * rl), cvtpk(o0[4 * gg + 2] * rl, o0[4 * gg + 3] * rl)};
                u32x2 w1 = {cvtpk(o1[4 * gg] * rl, o1[4 * gg + 1] * rl), cvtpk(o1[4 * gg + 2] * rl, o1[4 * gg + 3] * rl)};
                *(u32x2*)(op + 8 * gg + 4 * hi) = w0; *(u32x2*)(op + 32 + 8 * gg + 4 * hi) = w1;
            }
            if (hi == 0) TL[g * 512 + tl] = m + __builtin_amdgcn_logf(l);
        }
    }
    __threadfence_block();
    __syncthreads();
    {
        const float e0 = TL[tid], e1 = TL[512 + tid], e2 = TL[1024 + tid];
        const float mx = fmaxf(e0, fmaxf(e1, e2));
        float w0 = __builtin_amdgcn_exp2f(e0 - mx), w1 = __builtin_amdgcn_exp2f(e1 - mx), w2 = __builtin_amdgcn_exp2f(e2 - mx);
        const float rs = 1.0f / (w0 + w1 + w2); w0 *= rs; w1 *= rs; w2 *= rs;
        const u32x4* p0 = (const u32x4*)(TO + (size_t)tid * 64); const u32x4* p1 = (const u32x4*)(TO + ((size_t)512 + tid) * 64); const u32x4* p2 = (const u32x4*)(TO + ((size_t)1024 + tid) * 64);
        u32x4* yo = (u32x4*)(YA + ((size_t)b * SEQ + s0 + tid) * 512 + slot * 128);
#pragma unroll
        for (int i = 0; i < 8; ++i) { const u32x4 x0 = p0[i], x1 = p1[i], x2 = p2[i]; u32x4 y;
#pragma unroll
            for (int e = 0; e < 4; ++e) y[e] = cvtpk(w0 * bf_lo(x0[e]) + w1 * bf_lo(x1[e]) + w2 * bf_lo(x2[e]), w0 * bf_hi(x0[e]) + w1 * bf_hi(x1[e]) + w2 * bf_hi(x2[e]));
            yo[i] = y; }
    }
    __syncthreads();
}

__device__ __forceinline__ void phase_attn(KArgs a, LAS unsigned char* lds, int tid, int lane, int wid) {
    const int G = gridDim.x, bx = blockIdx.x; const int vcu = (G % 8 == 0) ? (bx % 8) * (G / 8) + bx / 8 : bx;
    for (int item = vcu; item < 256; item += G) {
        const int bh = item >> 3, s = item & 7;
        fox_unit(a, lds, bh >> 2, bh & 3, s, tid, lane, wid);
        fox_unit(a, lds, bh >> 2, bh & 3, 15 - s, tid, lane, wid);
        dil_item(a, lds, item, tid, lane, wid);
    }
}

#define XB_TMO      128
#define XB_XCNT(j)  (256  + 64 * (j))
#define XB_XSUB(j)  (1280 + 64 * (j))
#define XB_XGEN(j)  (2304 + 64 * (j))
#define XB_TOP      3328
#define XB_TOPGEN   3392
#define XCD_BAR_WORDS 3456
#define XB_SPIN_CAP (1u << 18)
__device__ __forceinline__ unsigned xb_ld(unsigned* p)              { return __hip_atomic_load(p, __ATOMIC_RELAXED, __HIP_MEMORY_SCOPE_AGENT); }
__device__ __forceinline__ unsigned xb_add(unsigned* p, unsigned v) { return __hip_atomic_fetch_add(p, v, __ATOMIC_RELAXED, __HIP_MEMORY_SCOPE_AGENT); }
__device__ __forceinline__ unsigned xb_xcc_id() { return (unsigned)__builtin_amdgcn_s_getreg((3 << 11) | 20) & 0xFu; }
#define XB_SPIN(cond, bar) do { unsigned _sp = 0; while (cond) { __builtin_amdgcn_s_sleep(1); \
    if ((++_sp & 255u) == 0u) { if (xb_ld(&(bar)[XB_TMO])) break; if (_sp > XB_SPIN_CAP) { atomicAdd(&(bar)[XB_TMO], 1u); break; } } } } while (0)
struct XcdBarrier { unsigned* bar; unsigned x; volatile LAS unsigned* st; };
__device__ __forceinline__ XcdBarrier xcd_barrier_post(unsigned* bar, volatile LAS unsigned* st) {
    XcdBarrier b; b.bar = bar; b.x = xb_xcc_id(); b.st = st;
    if (threadIdx.x == 0) (void)xb_add(&bar[XB_XCNT(b.x)], 1u);
    return b;
}
__device__ __forceinline__ void xcd_barrier_complete(unsigned* bar, unsigned x, unsigned& nloc, unsigned& nx) {
    const unsigned G = gridDim.x * gridDim.y * gridDim.z;
    unsigned sum, cnt, mine, sp = 0u;
    for (;;) {
        sum = 0u; cnt = 0u; mine = 0u;
#pragma unroll
        for (unsigned j = 0; j < 16; ++j) { const unsigned c = xb_ld(&bar[XB_XCNT(j)]); sum += c; cnt += (c > 0u) ? 1u : 0u; mine = (j == x) ? c : mine; }
        if (sum == G) break;
        __builtin_amdgcn_s_sleep(1);
        if ((++sp & 255u) == 0u) { if (xb_ld(&bar[XB_TMO])) break; if (sp > XB_SPIN_CAP) { atomicAdd(&bar[XB_TMO], 1u); break; } }
    }
    nloc = mine > 0u ? mine : 1u; nx = cnt > 0u ? cnt : 1u;
}
__device__ __forceinline__ void xcd_barrier(const XcdBarrier& b, const int tid0) {
    asm volatile("s_waitcnt vmcnt(0)" ::: "memory");
    __syncthreads();
    if (tid0 == 0) {
        unsigned* bar = b.bar;
        __builtin_amdgcn_s_waitcnt(0);
        unsigned nloc = b.st[0], nx = b.st[1];
        if (nloc == 0u) { xcd_barrier_complete(bar, b.x, nloc, nx); b.st[0] = nloc; b.st[1] = nx; }
        const unsigned old = xb_add(&bar[XB_XSUB(b.x)], 1u);
        const unsigned gen = old / nloc;
        if (old + 1u == (gen + 1u) * nloc) {
            __builtin_amdgcn_fence(__ATOMIC_RELEASE, "agent");
            asm volatile("s_waitcnt vmcnt(0)" ::: "memory");
            (void)xb_add(&bar[XB_TOP], 1u);
        }
        XB_SPIN(xb_ld(&bar[XB_TOP]) < nx * (gen + 1u), bar);
        __builtin_amdgcn_fence(__ATOMIC_ACQUIRE, "agent");
        asm volatile("s_waitcnt vmcnt(0)" ::: "memory");
    }
    __syncthreads();
}

__global__ void __launch_bounds__(512, 2) mk_fwd(Args karg) {
    extern __shared__ __attribute__((aligned(16))) unsigned char lds_raw[];
    LAS unsigned char* lds = (LAS unsigned char*)lds_raw;
    const int G = gridDim.x, bx = blockIdx.x;
    const int ph_lo = karg.ph_lo, ph_hi = karg.ph_hi;
    const int wid0 = __builtin_amdgcn_readfirstlane((int)threadIdx.x >> 6);
    if (threadIdx.x < 2) ((LAS unsigned*)(lds + LDS_MISC))[16 + threadIdx.x] = 0u;
    __syncthreads();
    const XcdBarrier bar = xcd_barrier_post((unsigned*)(karg.ws + WS_CTL), (volatile LAS unsigned*)(lds + LDS_MISC) + 16);
#pragma unroll 1
    for (int ph = ph_lo; ph < ph_hi; ++ph) {
        if (ph_hi > 1000) cg::this_grid().sync();
        if (ph > ph_lo) xcd_barrier(bar, (wid0 << 6) | (int)__builtin_amdgcn_mbcnt_hi(~0u, __builtin_amdgcn_mbcnt_lo(~0u, 0u)));
        KArgs a = (KArgs)__builtin_amdgcn_kernarg_segment_ptr(); asm volatile("" : "+s"(a));
#define MK_TID() int tid = (wid0 << 6) | (int)__builtin_amdgcn_mbcnt_hi(~0u, __builtin_amdgcn_mbcnt_lo(~0u, 0u)); asm volatile("" : "+v"(tid)); const int lane = tid & 63, wid = wid0
        unsigned char* ws = a->ws;
        bf16_t* H = (bf16_t*)(ws + WS_H); bf16_t* Zb = (bf16_t*)(ws + WS_Z); bf16_t* Y = (bf16_t*)(ws + WS_Y);
        if (ph == 0) { MK_TID(); phase_prologue(a, lds, tid, lane, wid); continue; }
        if (ph == NPHASE - 1) { MK_TID(); phase_norm<3>(a, 0, lds, tid, lane, wid); continue; }
        const int l = (ph - 1) / 8, sp = (ph - 1) % 8;
        if (sp == 0) { MK_TID(); phase_norm<1>(a, l, lds, tid, lane, wid); continue; }
        if (sp == 5) { MK_TID(); phase_norm<2>(a, l, lds, tid, lane, wid); continue; }
        if (sp == 2) { MK_TID(); phase_attn(a, lds, tid, lane, wid); continue; }
        if (sp == 1) { MK_TID(); phase_scan(a, lds, tid, lane, wid); }
        const unsigned char* wl = ws + WS_W + (size_t)l * W_LAYER;
        const float* modl = (const float*)(ws + WS_MOD) + (size_t)l * 8 * NMODC;
        pg8::Gemm g; EpiAny E; int N;
        g.M = T_TOK; g.zskip = 0; E.g = nullptr; E.src = nullptr;
        switch (sp) {
        case 1: g.A = H; g.Bt = (const bf16_t*)(wl + WO_IN); N = ZP; g.K = DM; E.mode = 0; E.dst = Zb; break;
        case 3: g.A = Y; g.Bt = (const bf16_t*)(wl + WO_UP); N = 2 * DM; g.K = 512; g.zskip = 1; E.mode = 1; E.src = Zb + ZO_G; E.dst = H; break;
        case 4: g.A = H; g.Bt = (const bf16_t*)(wl + WO_OUT); N = DM; g.K = DM; E.mode = 3; E.src = (l == 0) ? (const void*)a->in[0] : (const void*)a->out; E.dst = a->out; E.g = modl + 2 * DM; break;
        case 6: g.A = H; g.Bt = (const bf16_t*)(wl + WO_FFI); N = 2 * DFF; g.K = DM; E.mode = 4; E.dst = Zb; break;
        default: g.A = Zb; g.Bt = (const bf16_t*)(wl + WO_FFO); N = DM; g.K = DFF; E.mode = 3; E.src = a->out; E.dst = a->out; E.g = modl + 5 * DM; break;
        }
        g.N = N;
        pg8::StaticOrder S; S.init(T_TOK, N, G, bx, sp == 1 ? 12 : 0);
        if (sp == 3) { MK_TID(); (void)lane; (void)wid; EpiUpOnly EU{Zb + ZO_G, H}; pg8::gemm_phase<EpiUpOnly, pg8::StaticOrder, true, true, true>(lds, g, S, EU, tid); }
        else { MK_TID(); (void)lane; (void)wid; pg8::gemm_phase<EpiAny, pg8::StaticOrder, true, true, false>(lds, g, S, E, tid); }
    }
}

extern "C" void kernel_launch(void* const* d_in, const int* in_sizes, int n_in, void* d_out, int out_size, void* d_ws, size_t ws_size, hipStream_t stream) {
    static int grid = 0;
    if (grid == 0) {
        if (n_in != 14 || in_sizes[0] != T_TOK * DM || out_size != T_TOK * DM || ws_size < WS_END) { fprintf(stderr, "kernel_launch: unexpected shapes / workspace (n_in %d, ws %zu)\n", n_in, ws_size); grid = -1; return; }
        int dev = 0, cus = 0, per_cu = 0;
        if (hipGetDevice(&dev) != hipSuccess || hipDeviceGetAttribute(&cus, hipDeviceAttributeMultiprocessorCount, dev) != hipSuccess) { grid = -1; return; }
        if (hipFuncSetAttribute((const void*)mk_fwd, hipFuncAttributeMaxDynamicSharedMemorySize, LDS_BYTES) != hipSuccess) { fprintf(stderr, "kernel_launch: hipFuncSetAttribute failed\n"); grid = -1; return; }
        if (hipOccupancyMaxActiveBlocksPerMultiprocessor(&per_cu, (const void*)mk_fwd, 512, LDS_BYTES) != hipSuccess || per_cu < 1) { fprintf(stderr, "kernel_launch: occupancy query failed (%d)\n", per_cu); (void)hipGetLastError(); grid = -1; return; }
        grid = cus * 1;
    }
    if (grid < 0) return;
    if (hipMemsetAsync((char*)d_ws + WS_CTL, 0, CTL_BYTES, stream) != hipSuccess) { fprintf(stderr, "kernel_launch: memset of barrier words failed\n"); return; }
    Args a{};
    for (int i = 0; i < 14; ++i) a.in[i] = (const float*)d_in[i];
    a.out = (float*)d_out; a.ws = (unsigned char*)d_ws;
#if MK_MULTI
    for (int ph = 0; ph < NPHASE; ++ph) { a.ph_lo = ph; a.ph_hi = ph + 1; hipLaunchKernelGGL(mk_fwd, dim3(grid), dim3(512), LDS_BYTES, stream, a); }
#else
    a.ph_lo = 0; a.ph_hi = NPHASE;
    void* args[] = {&a};
    hipError_t e = hipLaunchCooperativeKernel((void*)mk_fwd, dim3(grid), dim3(512), args, LDS_BYTES, stream);
    if (e != hipSuccess) fprintf(stderr, "cooperative launch failed: %s (grid %d)\n", hipGetErrorString(e), grid);
#endif
}
```

```cpp
#include <hip/hip_runtime.h>
#include <hip/hip_cooperative_groups.h>
#include <cstdio>
#include <cstdint>
namespace cg = cooperative_groups;

#ifndef MK_MULTI
#define MK_MULTI 0
#endif

#define LAS __attribute__((address_space(3)))
typedef unsigned short bf16_t;
typedef short bf16x8 __attribute__((ext_vector_type(8)));
typedef short s16x4 __attribute__((ext_vector_type(4)));
typedef float f32x4 __attribute__((ext_vector_type(4)));
typedef float f32x2 __attribute__((ext_vector_type(2)));
typedef float f32x16 __attribute__((ext_vector_type(16)));
typedef unsigned u32x4 __attribute__((ext_vector_type(4)));
typedef unsigned u32x2 __attribute__((ext_vector_type(2)));
typedef __bf16 bf16x2_t __attribute__((ext_vector_type(2)));

__device__ __forceinline__ unsigned cvtpk(float lo, float hi) { f32x2 v = {lo, hi}; bf16x2_t b = __builtin_convertvector(v, bf16x2_t); return __builtin_bit_cast(unsigned, b); }
__device__ __forceinline__ float bf_lo(unsigned w) { return __uint_as_float(w << 16); }
__device__ __forceinline__ float bf_hi(unsigned w) { return __uint_as_float(w & 0xffff0000u); }
__device__ __forceinline__ float sigmoidf_fast(float x) { return __builtin_amdgcn_rcpf(1.0f + __builtin_amdgcn_exp2f(-1.4426950408889634f * x)); }

namespace pg8 {
constexpr int BM = 256, BK = 64, HALF = 128, HTB = HALF * BK * 2, STAGE_BYTES = 8 * HTB, NXCD = 8, WGM = 8;
__host__ __device__ __forceinline__ int lds_byte(int r, int c) { const int st = (r >> 4) * 2 + (c >> 5), rr = r & 15, cc = c & 31, ob = rr * 64 + cc * 2; return st * 1024 + (ob ^ (((ob >> 9) & 1) << 5)); }
__host__ __device__ __forceinline__ void stage_rc(int b, int& R, int& C) { const int st = b / 1024, sb = b % 1024, swz = sb ^ (((sb >> 9) & 1) << 5); R = (st >> 1) * 16 + swz / 64; C = (st & 1) * 32 + (swz % 64) / 2; }
__host__ __device__ __forceinline__ int perm32(int rho) { const int n = rho >> 4, i = rho & 15; return 8 * (i >> 2) + 4 * n + (i & 3); }
struct Unit { int pm, pn; };
struct Gemm { const bf16_t* A; const bf16_t* Bt; int M, N, K; int zskip; };
struct StaticOrder {
    int nM, nN, nwg, G, c, rot;
    __host__ __device__ void init(int M, int N, int G_, int c_, int rot_ = 0) { nM = M / BM; nN = N / BM; nwg = nM * nN; G = G_; c = c_; rot = rot_; }
    __host__ __device__ bool next(int i, Unit& u) const {
        const long L = (long)i * G + c; if (L >= nwg) return false;
        int wgid = (int)L; { const int q = nwg / NXCD, r = nwg % NXCD, xcd = wgid % NXCD, off = wgid / NXCD; wgid = (xcd < r ? xcd * (q + 1) : r * (q + 1) + (xcd - r) * q) + off; }
        const int nig = WGM * nN, gid = wgid / nig, fm = gid * WGM, gsz = (nM - fm) < WGM ? (nM - fm) : WGM;
        u.pm = fm + ((wgid % nig) % gsz); u.pn = (wgid % nig) / gsz + rot; if (u.pn >= nN) u.pn -= nN; return true;
    }
    __device__ __forceinline__ void a_ready(const Unit&) const {}
    __device__ __forceinline__ void done(const Unit&) const {}
};

template <class Epi, class Sched, bool ALIGN_EPI = false, bool SP2 = false, bool ZSKIP = false>
__device__ __forceinline__ void gemm_phase(LAS unsigned char* lds, const Gemm g, const Sched& S, const Epi& E, const int tid) {
    const int wid = __builtin_amdgcn_readfirstlane(tid >> 6), lane = tid & 63, wr = wid >> 2, wc = wid & 3, fr = lane & 15, fq = lane >> 4;
    const int K = g.K, nt = K / BK;
    unsigned voffA[2], voffB[2];
#pragma unroll
    for (int i = 0; i < 2; ++i) { int R, C; stage_rc(tid * 16 + i * 8192, R, C); const int Rb = Epi::PERM ? ((R & ~31) + perm32(R & 31)) : R;
        voffA[i] = (unsigned)(R * K + C) * 2u; voffB[i] = (unsigned)(Rb * K + C) * 2u; }
    const size_t kstep = (size_t)(BK * 2);
    const size_t hstep = (size_t)HALF * K * 2;
    const size_t tstep = 2 * hstep;
    const unsigned ldsw = (unsigned)wid * 1024u;
    const int aoff = lds_byte(wr * 64 + fr, fq * 8), boff = lds_byte(wc * 32 + fr, fq * 8);
#define PG8_SA(b, h) (((b) * 2 + (h)) * HTB)
#define PG8_SB(b, h) ((4 + (b) * 2 + (h)) * HTB)
#define PG8_STAGE(bufoff, gbase, voff) do { _Pragma("unroll") for (int _i = 0; _i < 2; ++_i) \
        __builtin_amdgcn_global_load_lds((const unsigned*)((const char*)(gbase) + (voff)[_i]), (LAS unsigned*)(lds + (bufoff) + ldsw + _i * 8192), 16, 0, 0); } while (0)
#define PG8_LDA(dst, b, h) do { _Pragma("unroll") for (int m = 0; m < 4; ++m) _Pragma("unroll") for (int k = 0; k < 2; ++k) dst[m][k] = *(const LAS bf16x8*)(lds + PG8_SA(b, h) + aoff + m * 2048 + k * 1024); } while (0)
#define PG8_LDB(dst, b, h) do { _Pragma("unroll") for (int n = 0; n < 2; ++n) _Pragma("unroll") for (int k = 0; k < 2; ++k) dst[n][k] = *(const LAS bf16x8*)(lds + PG8_SB(b, h) + boff + n * 2048 + k * 1024); } while (0)
#define PG8_MMA(ai, bj, At, Bt) do { __builtin_amdgcn_s_setprio(1); _Pragma("unroll") for (int m = 0; m < 4; ++m) _Pragma("unroll") for (int n = 0; n < 2; ++n) _Pragma("unroll") for (int k = 0; k < 2; ++k) \
        acc[ai][bj][m][n] = __builtin_amdgcn_mfma_f32_16x16x32_bf16(Bt[n][k], At[m][k], acc[ai][bj][m][n], 0, 0, 0); __builtin_amdgcn_s_setprio(0); } while (0)
#define PG8_WAIT_V(n) asm volatile("s_waitcnt vmcnt(" #n ")" ::: "memory")
#define PG8_WAIT_L(n) asm volatile("s_waitcnt lgkmcnt(" #n ")" ::: "memory")
#define PG8_BAR __builtin_amdgcn_s_barrier()
#define PG8_SCHED __builtin_amdgcn_sched_barrier(0)
    Unit cur, nxt; int ui = 0;
    if (!S.next(0, cur)) return;
    f32x4 acc[2][2][4][2];
#pragma unroll
    for (int a = 0; a < 2; ++a)
#pragma unroll
        for (int b = 0; b < 2; ++b)
#pragma unroll
            for (int m = 0; m < 4; ++m)
#pragma unroll
                for (int n = 0; n < 2; ++n) acc[a][b][m][n] = (f32x4){0.f, 0.f, 0.f, 0.f};
    bf16x8 At[4][2], B0[2][2], B1[2][2];
    const char* cA = (const char*)g.A + (size_t)cur.pm * tstep; const char* cB = (const char*)g.Bt + (size_t)cur.pn * tstep;
    S.a_ready(cur);
    if constexpr (SP2) {
        PG8_STAGE(PG8_SB(0, 0), cB, voffB); PG8_STAGE(PG8_SB(0, 1), cB + hstep, voffB); PG8_STAGE(PG8_SA(0, 0), cA, voffA); PG8_STAGE(PG8_SA(0, 1), cA + hstep, voffA);
        if (wr == 1) PG8_BAR;
        PG8_WAIT_V(2); PG8_BAR;
        PG8_STAGE(PG8_SB(1, 0), cB + kstep, voffB); PG8_STAGE(PG8_SA(1, 0), cA + kstep, voffA); PG8_STAGE(PG8_SB(1, 1), cB + hstep + kstep, voffB);
        PG8_WAIT_V(6); PG8_BAR;
    } else {
        PG8_STAGE(PG8_SB(0, 0), cB, voffB); PG8_STAGE(PG8_SA(0, 0), cA, voffA); PG8_STAGE(PG8_SB(0, 1), cB + hstep, voffB); PG8_STAGE(PG8_SA(0, 1), cA + hstep, voffA);
        if (wr == 1) PG8_BAR;
        PG8_WAIT_V(4); PG8_BAR;
        PG8_STAGE(PG8_SB(1, 0), cB + kstep, voffB); PG8_STAGE(PG8_SA(1, 0), cA + kstep, voffA); PG8_STAGE(PG8_SB(1, 1), cB + hstep + kstep, voffB);
        PG8_WAIT_V(6); PG8_BAR;
    }
    for (;;) {
        const bool has_next = S.next(ui + 1, nxt);
        const char* nA = has_next ? (const char*)g.A + (size_t)nxt.pm * tstep : cA; const char* nB = has_next ? (const char*)g.Bt + (size_t)nxt.pn * tstep : cB;
        for (int t = 0; t < nt; t += 2) {
            const bool last = (t == nt - 2); const int zb = (2 * t >= nt) ? 1 : 0;
            const char* a1 = cA + (size_t)(t + 1) * kstep;
            const char* a2 = last ? nA : cA + (size_t)(t + 2) * kstep; const char* b2 = last ? nB : cB + (size_t)(t + 2) * kstep;
            const char* a3 = a2 + kstep; const char* b3 = b2 + kstep;
            if (last && has_next) S.a_ready(nxt);
            if constexpr (SP2) {
            PG8_LDB(B0, 0, 0); PG8_LDB(B1, 0, 1); PG8_SCHED; PG8_LDA(At, 0, 0); PG8_STAGE(PG8_SA(1, 1), a1 + hstep, voffA);
            PG8_WAIT_V(8); PG8_WAIT_L(0); PG8_BAR; PG8_MMA(0, 0, At, B0); if constexpr (!ZSKIP) PG8_MMA(0, 1, At, B1); PG8_BAR; PG8_SCHED;
            PG8_LDA(At, 0, 1); PG8_STAGE(PG8_SB(0, 0), b2, voffB); PG8_STAGE(PG8_SB(0, 1), b2 + hstep, voffB); PG8_STAGE(PG8_SA(0, 0), a2, voffA);
            PG8_WAIT_V(8); PG8_WAIT_L(0); PG8_BAR; PG8_MMA(1, 0, At, B0); if constexpr (!ZSKIP) PG8_MMA(1, 1, At, B1); PG8_BAR; PG8_SCHED;
            PG8_LDB(B0, 1, 0); PG8_LDB(B1, 1, 1); PG8_SCHED; PG8_LDA(At, 1, 0); PG8_STAGE(PG8_SA(0, 1), a2 + hstep, voffA);
            PG8_WAIT_V(8); PG8_WAIT_L(0); PG8_BAR; if constexpr (!ZSKIP) PG8_MMA(0, 0, At, B0); PG8_MMA(0, 1, At, B1); PG8_BAR; PG8_SCHED;
            PG8_LDA(At, 1, 1); PG8_STAGE(PG8_SB(1, 0), b3, voffB); PG8_STAGE(PG8_SB(1, 1), b3 + hstep, voffB); PG8_STAGE(PG8_SA(1, 0), a3, voffA);
            PG8_WAIT_V(8); PG8_WAIT_L(0); PG8_BAR; if constexpr (!ZSKIP) PG8_MMA(1, 0, At, B0); PG8_MMA(1, 1, At, B1); PG8_BAR; PG8_SCHED;
            } else {
            PG8_LDB(B0, 0, 0); PG8_SCHED; PG8_LDA(At, 0, 0); PG8_STAGE(PG8_SA(1, 1), a1 + hstep, voffA);
            PG8_WAIT_L(8); PG8_BAR; PG8_WAIT_L(0); PG8_MMA(0, 0, At, B0); PG8_BAR; PG8_SCHED;
            PG8_LDB(B1, 0, 1); PG8_STAGE(PG8_SB(0, 0), b2, voffB);
            PG8_BAR; PG8_WAIT_L(0); PG8_MMA(0, 1, At, B1); PG8_BAR;
            PG8_LDA(At, 0, 1); PG8_STAGE(PG8_SA(0, 0), a2, voffA);
            PG8_BAR; PG8_WAIT_L(0); PG8_MMA(1, 0, At, B0); PG8_BAR; PG8_SCHED;
            PG8_STAGE(PG8_SB(0, 1), b2 + hstep, voffB);
            PG8_WAIT_V(6); PG8_BAR; PG8_MMA(1, 1, At, B1); PG8_BAR;
            PG8_LDB(B0, 1, 0); PG8_SCHED; PG8_LDA(At, 1, 0); PG8_STAGE(PG8_SA(0, 1), a2 + hstep, voffA);
            PG8_WAIT_L(8); PG8_BAR; PG8_WAIT_L(0); PG8_MMA(0, 0, At, B0); PG8_BAR; PG8_SCHED;
            PG8_LDB(B1, 1, 1); PG8_STAGE(PG8_SB(1, 0), b3, voffB);
            PG8_BAR; PG8_WAIT_L(0); PG8_MMA(0, 1, At, B1); PG8_BAR;
            PG8_LDA(At, 1, 1); PG8_STAGE(PG8_SA(1, 0), a3, voffA);
            PG8_BAR; PG8_WAIT_L(0); PG8_MMA(1, 0, At, B0); PG8_BAR; PG8_SCHED;
            PG8_STAGE(PG8_SB(1, 1), b3 + hstep, voffB);
            PG8_WAIT_V(6); PG8_BAR; PG8_MMA(1, 1, At, B1); PG8_BAR;
            }
        }
        if constexpr (ALIGN_EPI) { if (wr == 0) PG8_BAR; }
        E(acc, cur, wr, wc, fr, fq); S.done(cur);
        if (!has_next) break;
#pragma unroll
        for (int a = 0; a < 2; ++a)
#pragma unroll
            for (int b = 0; b < 2; ++b)
#pragma unroll
                for (int m = 0; m < 4; ++m)
#pragma unroll
                    for (int n = 0; n < 2; ++n) acc[a][b][m][n] = (f32x4){0.f, 0.f, 0.f, 0.f};
        cur = nxt; cA = nA; cB = nB; ++ui;
        if constexpr (ALIGN_EPI) { if (wr == 1) PG8_BAR; }
    }
    PG8_WAIT_V(0);
    if constexpr (!ALIGN_EPI) { if (wr == 0) PG8_BAR; }
    PG8_BAR;
#undef PG8_SA
#undef PG8_SB
#undef PG8_STAGE
#undef PG8_LDA
#undef PG8_LDB
#undef PG8_MMA
#undef PG8_WAIT_V
#undef PG8_WAIT_L
#undef PG8_BAR
#undef PG8_SCHED
}
}

constexpr int T_TOK = 32768, DM = 1024, SEQ = 4096, NBATCH = 8, DIN = 5124, ZP = 5120, DFF = 2816, NMODC = 6144;
constexpr int GP = 2048;
constexpr size_t HM_A = (size_t)8 * 12 * 4096 * 64, HM_B = (size_t)8 * 4 * 4096 * 64;
constexpr size_t ZO_G = 0, ZO_QA = (size_t)T_TOK * GP, ZO_KA = ZO_QA + HM_A, ZO_VA = ZO_KA + HM_A, ZO_QB = ZO_VA + HM_A, ZO_KB = ZO_QB + HM_B, ZO_VB = ZO_KB + HM_B;
constexpr float LOG2E = 1.4426950408889634f;
constexpr float C2 = 0.125f * LOG2E;
constexpr size_t MiB = 1u << 20;
constexpr size_t WS_MOD = 0, WS_LOGF = 512 * 1024, WS_F2 = 1 * MiB, WS_CTL = 1536 * 1024, CTL_BYTES = 16384, WS_W = 2 * MiB, W_LAYER = 32 * MiB;
constexpr size_t WO_IN = 0, WO_OUT = 11534336, WO_FFI = 13631488, WO_FFO = 25165824, WO_UP = 30932992;
constexpr size_t WS_H = 66 * MiB, WS_Y = 130 * MiB, WS_Z = 162 * MiB, WS_END = 482 * MiB;
constexpr int LDS_RING = 131072, LDS_MISC = LDS_RING, LDS_BYTES = LDS_RING + 1024;
constexpr int NPHASE = 18;

typedef const f32x4 (&AccRef)[2][2][4][2];
__device__ __forceinline__ void epi_z(AccRef acc, const pg8::Unit& u, int wr, int wc, int fr, int fq, bf16_t* Z) {
    const int pn = u.pn; const int row0 = u.pm * 256 + wr * 64 + fr;
    if (pn >= 12) {
        const int col0 = (pn - 12) * 256 + wc * 32 + 8 * fq;
#pragma unroll
        for (int ai = 0; ai < 2; ++ai)
#pragma unroll
            for (int m = 0; m < 4; ++m) { bf16_t* rowp = Z + ZO_G + (size_t)(row0 + ai * 128 + m * 16) * GP + col0;
#pragma unroll
                for (int bj = 0; bj < 2; ++bj) { f32x4 v0 = acc[ai][bj][m][0], v1 = acc[ai][bj][m][1];
#pragma unroll
                    for (int e = 0; e < 4; ++e) { v0[e] = sigmoidf_fast(v0[e]); v1[e] = sigmoidf_fast(v1[e]); }
                    u32x4 w; w.x = cvtpk(v0[0], v0[1]); w.y = cvtpk(v0[2], v0[3]); w.z = cvtpk(v1[0], v1[1]); w.w = cvtpk(v1[2], v1[3]);
                    *(u32x4*)(rowp + bj * 128) = w; } }
        return;
    }
    const bool isA = pn < 9; const int sec = isA ? pn / 3 : pn - 9, g = isA ? pn % 3 : 0, sh = 2 * g;
    const float sc = (sec == 0) ? C2 : 1.0f;
    bf16_t* base = Z + (isA ? ZO_QA + (size_t)sec * HM_A : ZO_QB + (size_t)sec * HM_B);
    const int b = u.pm >> 4, nh = isA ? 12 : 4;
    const int dc = ((wc & 1) * 32 + 8 * fq);
#pragma unroll
    for (int ai = 0; ai < 2; ++ai)
#pragma unroll
        for (int m = 0; m < 4; ++m) { const int srow = (row0 + ai * 128 + m * 16) & (SEQ - 1);
            const int pos = ((srow & ((1 << sh) - 1)) << (12 - sh)) + (srow >> sh);
#pragma unroll
            for (int bj = 0; bj < 2; ++bj) { const int head = g * 4 + bj * 2 + (wc >> 1);
                f32x4 v0 = acc[ai][bj][m][0] * sc, v1 = acc[ai][bj][m][1] * sc;
                u32x4 w; w.x = cvtpk(v0[0], v0[1]); w.y = cvtpk(v0[2], v0[3]); w.z = cvtpk(v1[0], v1[1]); w.w = cvtpk(v1[2], v1[3]);
                *(u32x4*)(base + ((size_t)(b * nh + head) * SEQ + pos) * 64 + dc) = w; } }
}
__device__ __forceinline__ void epi_up(AccRef acc, const pg8::Unit& u, int wr, int wc, int fr, int fq, const bf16_t* G, bf16_t* O) {
    const int row0 = u.pm * 256 + wr * 64 + fr, col0 = u.pn * 128 + wc * 32 + 8 * fq;
#pragma unroll
    for (int ai = 0; ai < 2; ++ai) {
        u32x4 ga[4], gb[4];
#pragma unroll
        for (int m = 0; m < 4; ++m) { const size_t row = (size_t)(row0 + ai * 128 + m * 16); ga[m] = *(const u32x4*)(G + row * GP + col0); gb[m] = *(const u32x4*)(G + row * GP + 1024 + col0); }
#pragma unroll
        for (int m = 0; m < 4; ++m) { const size_t row = (size_t)(row0 + ai * 128 + m * 16);
            const f32x4 a0 = acc[ai][0][m][0], a1 = acc[ai][0][m][1], b0 = acc[ai][1][m][0], b1 = acc[ai][1][m][1]; f32x4 v0, v1;
            v0[0] = a0[0] * bf_lo(ga[m].x) + b0[0] * bf_lo(gb[m].x); v0[1] = a0[1] * bf_hi(ga[m].x) + b0[1] * bf_hi(gb[m].x); v0[2] = a0[2] * bf_lo(ga[m].y) + b0[2] * bf_lo(gb[m].y); v0[3] = a0[3] * bf_hi(ga[m].y) + b0[3] * bf_hi(gb[m].y);
            v1[0] = a1[0] * bf_lo(ga[m].z) + b1[0] * bf_lo(gb[m].z); v1[1] = a1[1] * bf_hi(ga[m].z) + b1[1] * bf_hi(gb[m].z); v1[2] = a1[2] * bf_lo(ga[m].w) + b1[2] * bf_lo(gb[m].w); v1[3] = a1[3] * bf_hi(ga[m].w) + b1[3] * bf_hi(gb[m].w);
            u32x4 w; w.x = cvtpk(v0[0], v0[1]); w.y = cvtpk(v0[2], v0[3]); w.z = cvtpk(v1[0], v1[1]); w.w = cvtpk(v1[2], v1[3]);
            *(u32x4*)(O + row * DM + col0) = w; }
        asm volatile("" ::: "memory"); }
}
__device__ __forceinline__ void epi_res(AccRef acc, const pg8::Unit& u, int wr, int wc, int fr, int fq, const float* xin, float* xout, const float* g) {
    const float* gb = g + (size_t)(u.pm >> 4) * NMODC; const int col0 = u.pn * 256 + wc * 32 + 8 * fq;
    f32x4 gv[2][2];
#pragma unroll
    for (int bj = 0; bj < 2; ++bj)
#pragma unroll
        for (int n = 0; n < 2; ++n) gv[bj][n] = *(const f32x4*)(gb + col0 + bj * 128 + n * 4);
#pragma unroll
    for (int ai = 0; ai < 2; ++ai) {
        f32x4 xv[4][2][2];
#pragma unroll
        for (int m = 0; m < 4; ++m) { const size_t off = (size_t)(u.pm * 256 + ai * 128 + wr * 64 + m * 16 + fr) * DM + col0;
#pragma unroll
            for (int bj = 0; bj < 2; ++bj)
#pragma unroll
                for (int n = 0; n < 2; ++n) xv[m][bj][n] = *(const f32x4*)(xin + off + bj * 128 + n * 4); }
#pragma unroll
        for (int m = 0; m < 4; ++m) { const size_t off = (size_t)(u.pm * 256 + ai * 128 + wr * 64 + m * 16 + fr) * DM + col0;
#pragma unroll
            for (int bj = 0; bj < 2; ++bj)
#pragma unroll
                for (int n = 0; n < 2; ++n) *(f32x4*)(xout + off + bj * 128 + n * 4) = xv[m][bj][n] + gv[bj][n] * acc[ai][bj][m][n]; }
        asm volatile("" ::: "memory"); }
}
__device__ __forceinline__ void epi_swi(AccRef acc, const pg8::Unit& u, int wr, int wc, int fr, int fq, bf16_t* O) {
    const int row0 = u.pm * 256 + wr * 64 + fr, col0 = u.pn * 128 + wc * 32 + 8 * fq;
#pragma unroll
    for (int ai = 0; ai < 2; ++ai)
#pragma unroll
        for (int m = 0; m < 4; ++m) { f32x4 h0, h1;
#pragma unroll
            for (int e = 0; e < 4; ++e) { const float g0 = acc[ai][0][m][0][e], g1 = acc[ai][0][m][1][e];
                h0[e] = g0 * sigmoidf_fast(g0) * acc[ai][1][m][0][e]; h1[e] = g1 * sigmoidf_fast(g1) * acc[ai][1][m][1][e]; }
            u32x4 w; w.x = cvtpk(h0[0], h0[1]); w.y = cvtpk(h0[2], h0[3]); w.z = cvtpk(h1[0], h1[1]); w.w = cvtpk(h1[2], h1[3]);
            *(u32x4*)(O + (size_t)(row0 + ai * 128 + m * 16) * DFF + col0) = w; }
}
struct EpiUpOnly {
    static constexpr bool PERM = true;
    const bf16_t* G; bf16_t* O;
    __device__ __forceinline__ void operator()(AccRef acc, const pg8::Unit& u, int wr, int wc, int fr, int fq) const { epi_up(acc, u, wr, wc, fr, fq, G, O); }
};
struct EpiAny {
    static constexpr bool PERM = true;
    int mode; const void* src; void* dst; const float* g;
    __device__ __forceinline__ void operator()(AccRef acc, const pg8::Unit& u, int wr, int wc, int fr, int fq) const {
        switch (mode) {
        case 0: epi_z(acc, u, wr, wc, fr, fq, (bf16_t*)dst); break;
        case 3: epi_res(acc, u, wr, wc, fr, fq, (const float*)src, (float*)dst, g); break;
        default: epi_swi(acc, u, wr, wc, fr, fq, (bf16_t*)dst); break;
        }
    }
};

__device__ __forceinline__ float lane_xor(float v, int o, int lane) { return __int_as_float(__builtin_amdgcn_ds_bpermute((lane ^ o) << 2, __float_as_int(v))); }
__device__ __forceinline__ float wave_sum(float v, int lane) {
#pragma unroll
    for (int o = 1; o < 64; o <<= 1) v += lane_xor(v, o, lane);
    return v;
}
__device__ __forceinline__ int crow(int r, int hi) { return (r & 3) + 8 * (r >> 2) + 4 * hi; }

__device__ __forceinline__ void zero_item(bf16_t* WT, int K, int dstrow, int k0, int lane) {
    const int c = lane & 7;
#pragma unroll
    for (int j = 0; j < 4; ++j) { const int n = (lane >> 3) + 8 * j; *(u32x4*)(WT + (size_t)(dstrow + n) * K + k0 + 8 * c) = (u32x4){0u, 0u, 0u, 0u}; }
}
__device__ __forceinline__ void transpose_item(const float* W, int ldw, int srccol, bf16_t* WT, int K, int dstrow, int k0, LAS float* scr, int lane, int srck0 = -1) {
    if (srck0 < 0) srck0 = k0;
    float tv[32];
#pragma unroll
    for (int i = 0; i < 32; ++i) tv[i] = W[(size_t)(srck0 + 2 * i + (lane >> 5)) * ldw + srccol + (lane & 31)];
#pragma unroll
    for (int i = 0; i < 32; ++i) scr[(2 * i + (lane >> 5)) * 33 + (lane & 31)] = tv[i];
    asm volatile("s_waitcnt lgkmcnt(0)" ::: "memory");
    const int c = lane & 7;
#pragma unroll
    for (int j = 0; j < 4; ++j) { const int n = (lane >> 3) + 8 * j; const LAS float* s = scr + (8 * c) * 33 + n;
        u32x4 o; o.x = cvtpk(s[0 * 33], s[1 * 33]); o.y = cvtpk(s[2 * 33], s[3 * 33]); o.z = cvtpk(s[4 * 33], s[5 * 33]); o.w = cvtpk(s[6 * 33], s[7 * 33]);
        *(u32x4*)(WT + (size_t)(dstrow + n) * K + k0 + 8 * c) = o; }
    asm volatile("s_waitcnt lgkmcnt(0)" ::: "memory");
}

struct Args { const float* in[14]; float* out; unsigned char* ws; int ph_lo, ph_hi; };
typedef const __attribute__((address_space(4))) Args* KArgs;

__device__ __forceinline__ void phase_prologue(KArgs a, LAS unsigned char* lds, int tid, int lane, int wid) {
    const float* c = a->in[1]; const float* w_ada = a->in[2]; const float* b_ada = a->in[3];
    float* mod = (float*)(a->ws + WS_MOD);
    for (int cgp = blockIdx.x; cgp < 48; cgp += gridDim.x) {
        LAS float* cact = (LAS float*)lds;
        LAS float* red = (LAS float*)(lds + 32768);
        for (int i = tid; i < 8192; i += 512) { const int b = i >> 10, k = i & 1023; const float v = c[i]; cact[k * 8 + b] = v * sigmoidf_fast(v); }
        __syncthreads();
        const int l = cgp / 24, col0 = (cgp % 24) * 256;
        float acc[8][4];
#pragma unroll
        for (int b = 0; b < 8; ++b)
#pragma unroll
            for (int e = 0; e < 4; ++e) acc[b][e] = 0.f;
        const float* wp = w_ada + ((size_t)l * DM + wid * 128) * NMODC + col0 + 4 * lane;
#pragma unroll 32
        for (int k = 0; k < 128; ++k) {
            const f32x4 wv = *(const f32x4*)(wp + (size_t)k * NMODC);
            const f32x4 c0 = *(const LAS f32x4*)(cact + (wid * 128 + k) * 8), c1 = *(const LAS f32x4*)(cact + (wid * 128 + k) * 8 + 4);
#pragma unroll
            for (int e = 0; e < 4; ++e) { acc[0][e] += c0[0] * wv[e]; acc[1][e] += c0[1] * wv[e]; acc[2][e] += c0[2] * wv[e]; acc[3][e] += c0[3] * wv[e];
                                          acc[4][e] += c1[0] * wv[e]; acc[5][e] += c1[1] * wv[e]; acc[6][e] += c1[2] * wv[e]; acc[7][e] += c1[3] * wv[e]; }
        }
#pragma unroll
        for (int b = 0; b < 8; ++b)
#pragma unroll
            for (int e = 0; e < 4; ++e) red[(wid * 32 + b * 4 + e) * 64 + lane] = acc[b][e];
        __syncthreads();
#pragma unroll
        for (int i = 0; i < 4; ++i) { const int o = tid + 512 * i, b = o >> 8, cl = o & 255, ln = cl >> 2, e = cl & 3;
            float s = b_ada[(size_t)l * NMODC + col0 + cl];
#pragma unroll
            for (int w = 0; w < 8; ++w) s += red[(w * 32 + b * 4 + e) * 64 + ln];
            mod[((size_t)l * 8 + b) * NMODC + col0 + cl] = s; }
        __syncthreads();
    }
    LAS float* scr = (LAS float*)(lds + wid * 8448);
    const int gw = blockIdx.x * 8 + wid, NGW = gridDim.x * 8;
    constexpr int I_IN = 160 * 16, I_UP = 64 * 8, I_OUT = 32 * 16, I_FFI = 176 * 16, I_FFO = 32 * 44, I_LAYER = I_IN + I_UP + I_OUT + I_FFI + I_FFO;
    for (int it = gw; it < 2 * I_LAYER; it += NGW) {
        const int l = it / I_LAYER; int r = it % I_LAYER;
        unsigned char* wl = a->ws + WS_W + (size_t)l * W_LAYER;
        if (r < I_IN) { const int nb = r % 160, kb = r / 160, dr = nb * 32; transpose_item(a->in[5] + (size_t)l * DM * DIN, DIN, dr < 3072 ? dr : dr + 4, (bf16_t*)(wl + WO_IN), DM, dr, kb * 64, scr, lane); continue; } r -= I_IN;
        if (r < I_UP) {
            const int nb = r % 64, kb = r / 64, dr = nb * 32, pn = dr >> 8, w = dr & 255, br = w >> 7, ch = pn * 128 + (w & 127);
            if ((kb & 1) == br) transpose_item(a->in[br ? 8 : 7] + (size_t)l * 256 * DM, DM, ch, (bf16_t*)(wl + WO_UP), 512, dr, kb * 64, scr, lane, (kb >> 1) * 64);
            else zero_item((bf16_t*)(wl + WO_UP), 512, dr, kb * 64, lane);
            continue; } r -= I_UP;
        if (r < I_OUT) { const int nb = r % 32, kb = r / 32; transpose_item(a->in[9] + (size_t)l * DM * DM, DM, nb * 32, (bf16_t*)(wl + WO_OUT), DM, nb * 32, kb * 64, scr, lane); continue; } r -= I_OUT;
        if (r < I_FFI) { const int nb = r % 176, kb = r / 176, dr = nb * 32, pn = dr >> 8, wi = dr & 255; const int sc = wi < 128 ? pn * 128 + wi : DFF + pn * 128 + (wi - 128);
            transpose_item(a->in[11] + (size_t)l * DM * 2 * DFF, 2 * DFF, sc, (bf16_t*)(wl + WO_FFI), DM, dr, kb * 64, scr, lane); continue; } r -= I_FFI;
        { const int nb = r % 32, kb = r / 32; transpose_item(a->in[12] + (size_t)l * DFF * DM, DM, nb * 32, (bf16_t*)(wl + WO_FFO), DFF, nb * 32, kb * 64, scr, lane); }
    }
}

template <int SUB>
__device__ __forceinline__ void phase_norm(KArgs a, int l, LAS unsigned char* lds, int tid, int lane, int wid) {
    const float* xin = (SUB == 1 && l == 0) ? a->in[0] : a->out;
    const float* mod = (const float*)(a->ws + WS_MOD);
    bf16_t* H = (bf16_t*)(a->ws + WS_H);
    float* logf_out = (float*)(a->ws + WS_LOGF);
    LAS f32x4* Al = (LAS f32x4*)lds; LAS f32x4* Bl = (LAS f32x4*)(lds + 4096);
    for (int rb = blockIdx.x; rb < T_TOK / 128; rb += gridDim.x) {
        const int b = rb >> 5;
        const size_t rbase = (size_t)rb * 128 + wid * 16;
        constexpr int NPRE = (SUB == 1) ? 3 : 2;
        f32x4 vn[NPRE][4];
#pragma unroll
        for (int p = 0; p < NPRE; ++p)
#pragma unroll
            for (int j = 0; j < 4; ++j) vn[p][j] = *((const f32x4*)(xin + (rbase + p) * DM) + lane + 64 * j);
        __syncthreads();
        for (int i = tid; i < DM; i += 512) {
            float av, bv;
            if (SUB == 3) { av = a->in[13][i]; bv = 0.f; }
            else { const float* mb = mod + ((size_t)l * 8 + b) * NMODC; const float nw = (SUB == 1 ? a->in[4] : a->in[10])[l * DM + i];
                   av = nw * (1.0f + mb[(SUB == 1 ? 1 : 4) * DM + i]); bv = mb[(SUB == 1 ? 0 : 3) * DM + i]; }
            ((LAS float*)Al)[i] = av; ((LAS float*)Bl)[i] = bv;
        }
        __syncthreads();
        f32x4 wf[16]; float bfv[4] = {0.f, 0.f, 0.f, 0.f};
        if (SUB == 1) {
            const float* wfp = a->in[5] + (size_t)l * DM * DIN + 3072;
#pragma unroll
            for (int j = 0; j < 4; ++j)
#pragma unroll
                for (int e = 0; e < 4; ++e) wf[j * 4 + e] = *(const f32x4*)(wfp + (size_t)(4 * lane + 256 * j + e) * DIN);
#pragma unroll
            for (int n = 0; n < 4; ++n) bfv[n] = a->in[6][l * 4 + n];
        }
        auto do_row = [&](const f32x4 (&v)[4], const size_t row) __attribute__((always_inline)) {
            float ss = 0.f;
#pragma unroll
            for (int j = 0; j < 4; ++j) ss += (v[j].x * v[j].x + v[j].y * v[j].y) + (v[j].z * v[j].z + v[j].w * v[j].w);
            const float rstd = 1.0f / sqrtf(wave_sum(ss, lane) * (1.0f / DM) + 1e-6f);
            float fz[4] = {0.f, 0.f, 0.f, 0.f};
#pragma unroll
            for (int j = 0; j < 4; ++j) {
                const f32x4 hv = v[j] * rstd * Al[lane + 64 * j] + Bl[lane + 64 * j];
                if (SUB == 3) { *((f32x4*)(a->out + row * DM) + lane + 64 * j) = hv; }
                else { u32x2 w; w.x = cvtpk(hv[0], hv[1]); w.y = cvtpk(hv[2], hv[3]); *(u32x2*)(H + row * DM + 4 * lane + 256 * j) = w; }
                if (SUB == 1) {
#pragma unroll
                    for (int e = 0; e < 4; ++e)
#pragma unroll
                        for (int n = 0; n < 4; ++n) fz[n] += hv[e] * wf[j * 4 + e][n];
                }
            }
            if (SUB == 1) {
                f32x4 lf;
#pragma unroll
                for (int n = 0; n < 4; ++n) { const float y = wave_sum(fz[n], lane) + bfv[n];
                    const float e_ = __builtin_amdgcn_exp2f(-LOG2E * fabsf(y));
                    lf[n] = fminf(y, 0.f) - (e_ < 1e-3f ? e_ * (1.0f - 0.5f * e_) : 0.69314718056f * __builtin_amdgcn_logf(1.0f + e_)); }
                if (lane == 0) *(f32x4*)(logf_out + row * 4) = lf;
            }
        };
        if constexpr (SUB == 1) {
            constexpr int PD = 3;
#pragma unroll
            for (int i = 0; i < 16; ++i) {
                f32x4 v[4];
#pragma unroll
                for (int j = 0; j < 4; ++j) v[j] = vn[i % PD][j];
                if (i + PD < 16) {
#pragma unroll
                    for (int j = 0; j < 4; ++j) vn[i % PD][j] = *((const f32x4*)(xin + (rbase + i + PD) * DM) + lane + 64 * j); }
                do_row(v, rbase + i);
            }
        } else {
            for (int i = 0; i < 16; i += 2) {
                f32x4 v[2][4];
#pragma unroll
                for (int q = 0; q < 2; ++q)
#pragma unroll
                    for (int j = 0; j < 4; ++j) v[q][j] = vn[q][j];
                if (i + 2 < 16) {
#pragma unroll
                    for (int q = 0; q < 2; ++q)
#pragma unroll
                        for (int j = 0; j < 4; ++j) vn[q][j] = *((const f32x4*)(xin + (rbase + i + 2 + q) * DM) + lane + 64 * j); }
                do_row(v[0], rbase + i); do_row(v[1], rbase + i + 1);
            }
        }
    }
}

__device__ __forceinline__ void phase_scan(KArgs a, LAS unsigned char* lds, int tid, int lane, int wid) {
    const float* logf_in = (const float*)(a->ws + WS_LOGF); float* F2 = (float*)(a->ws + WS_F2);
    LAS float* wt = (LAS float*)(lds + LDS_MISC);
    for (int bh = blockIdx.x; bh < 32; bh += gridDim.x) {
        const int b = bh >> 2, h = bh & 3;
        float v[8]; float run = 0.f;
#pragma unroll
        for (int i = 0; i < 8; ++i) { run += logf_in[((size_t)b * SEQ + 8 * tid + i) * 4 + h]; v[i] = run; }
        float incl = run;
#pragma unroll
        for (int o = 1; o < 64; o <<= 1) { const float t = __int_as_float(__builtin_amdgcn_ds_bpermute(((lane - o) & 63) << 2, __float_as_int(incl))); if (lane >= o) incl += t; }
        __syncthreads();
        if (lane == 63) wt[wid] = incl;
        __syncthreads();
        float off = incl - run;
        for (int w = 0; w < wid; ++w) off += wt[w];
#pragma unroll
        for (int i = 0; i < 8; ++i) F2[(size_t)bh * SEQ + 8 * tid + i] = (v[i] + off) * LOG2E;
    }
    __syncthreads();
}

typedef short v4i16_t __attribute__((ext_vector_type(4)));
__device__ __forceinline__ s16x4 vtr(const LAS unsigned char* p) { return __builtin_bit_cast(s16x4, __builtin_amdgcn_ds_read_tr16_b64_v4i16((LAS v4i16_t*)p)); }
__device__ __forceinline__ float hmax2(float m) { auto rr = __builtin_amdgcn_permlane32_swap(__float_as_uint(m), __float_as_uint(m), false, false); return fmaxf(__uint_as_float(rr[0]), __uint_as_float(rr[1])); }
__device__ __forceinline__ float hsum2(float m) { auto rr = __builtin_amdgcn_permlane32_swap(__float_as_uint(m), __float_as_uint(m), false, false); return __uint_as_float(rr[0]) + __uint_as_float(rr[1]); }

#define ATT_THR 3.0f
template <int NS>
__device__ __forceinline__ void attn_qk(const bf16x8 (&kf)[NS][4], const bf16x8 (&qr)[4], f32x16 (&s)[NS]) {
#pragma unroll
    for (int d0 = 0; d0 < 4; ++d0)
#pragma unroll
        for (int i = 0; i < NS; ++i) s[i] = __builtin_amdgcn_mfma_f32_32x32x16_bf16(kf[i][d0], qr[d0], s[i], 0, 0, 0);
}
template <int NS>
__device__ __forceinline__ void attn_sm(f32x16 (&s)[NS], const LAS unsigned char* vb, int vhalf, bool first, float& m, float& l, f32x16& o0, f32x16& o1) {
    float rm = fmaxf(s[0][0], s[0][1]), rm2 = fmaxf(s[0][2], s[0][3]);
#pragma unroll
    for (int i = 0; i < NS; ++i)
#pragma unroll
        for (int r = (i == 0 ? 4 : 0); r < 16; r += 4) { rm = __builtin_fmaxf(__builtin_fmaxf(rm, s[i][r]), s[i][r + 1]); rm2 = __builtin_fmaxf(__builtin_fmaxf(rm2, s[i][r + 2]), s[i][r + 3]); }
    rm = fmaxf(rm, rm2);
    rm = hmax2(rm);
    if (first || __any(rm > ATT_THR)) {
        const float delta = first ? rm : fmaxf(rm, 0.f);
        m += delta;
        const float f = __builtin_amdgcn_exp2f(-delta);
        l *= f; o0 = o0 * f; o1 = o1 * f;
#pragma unroll
        for (int i = 0; i < NS; ++i) s[i] = s[i] - delta;
    }
    float ps = 0.f;
#pragma unroll
    for (int i = 0; i < NS; ++i)
#pragma unroll
        for (int r = 0; r < 16; ++r) { s[i][r] = __builtin_amdgcn_exp2f(s[i][r]); ps += s[i][r]; }
    l += ps;
#pragma unroll
    for (int i = 0; i < NS; ++i) {
        u32x4 p0 = {cvtpk(s[i][0], s[i][1]), cvtpk(s[i][2], s[i][3]), cvtpk(s[i][4], s[i][5]), cvtpk(s[i][6], s[i][7])};
        u32x4 p1 = {cvtpk(s[i][8], s[i][9]), cvtpk(s[i][10], s[i][11]), cvtpk(s[i][12], s[i][13]), cvtpk(s[i][14], s[i][15])};
        const bf16x8 pb0 = __builtin_bit_cast(bf16x8, p0), pb1 = __builtin_bit_cast(bf16x8, p1);
#pragma unroll
        for (int st = 0; st < 2; ++st) {
            const LAS unsigned char* vp = vb + i * 2048 + st * 1024;
            const s16x4 a0 = vtr(vp), a1 = vtr(vp + 512), b0 = vtr(vp + vhalf), b1 = vtr(vp + vhalf + 512);
            const bf16x8 vf0 = {a0[0], a0[1], a0[2], a0[3], a1[0], a1[1], a1[2], a1[3]}, vf1 = {b0[0], b0[1], b0[2], b0[3], b1[0], b1[1], b1[2], b1[3]};
            o0 = __builtin_amdgcn_mfma_f32_32x32x16_bf16(vf0, st ? pb1 : pb0, o0, 0, 0, 0);
            o1 = __builtin_amdgcn_mfma_f32_32x32x16_bf16(vf1, st ? pb1 : pb0, o1, 0, 0, 0);
        }
    }
}

__device__ __forceinline__ void fox_unit(KArgs a, LAS unsigned char* lds, int b, int h, int qb, int tid, int lane, int wid) {
    const bf16_t* Z = (const bf16_t*)(a->ws + WS_Z); const float* F2 = (const float*)(a->ws + WS_F2) + (size_t)(b * 4 + h) * SEQ; bf16_t* YB = (bf16_t*)(a->ws + WS_Y) + 64;
    const int r32 = lane & 31, hi = lane >> 5;
    constexpr int FB = 17664;
    const int qrow = qb * 256 + wid * 32 + r32; const size_t tok = (size_t)b * SEQ + qrow;
    bf16x8 qr[4];
#pragma unroll
    for (int d0 = 0; d0 < 4; ++d0) qr[d0] = *(const bf16x8*)(Z + ZO_QB + ((size_t)(b * 4 + h) * SEQ + qrow) * 64 + d0 * 16 + hi * 8);
    const float Fq = F2[qrow];
    const int wfirst = qb * 256 + wid * 32, wlast = wfirst + 31;
    const int NT = (qb + 1) * 4;
    const int lkey = tid >> 3, lch = tid & 7;
    const bf16_t* ksrc = Z + ZO_KB + ((size_t)(b * 4 + h) * SEQ + lkey) * 64 + lch * 8;
    const bf16_t* vsrc = Z + ZO_VB + ((size_t)(b * 4 + h) * SEQ + lkey) * 64 + lch * 8;
    u32x4 kr0 = *(const u32x4*)(ksrc + (size_t)(NT - 1) * 64 * 64), vr0 = *(const u32x4*)(vsrc + (size_t)(NT - 1) * 64 * 64); float fr0 = (tid < 64) ? F2[(NT - 1) * 64 + tid] : 0.f;
    u32x4 kr1 = *(const u32x4*)(ksrc + (size_t)(NT - 2) * 64 * 64), vr1 = *(const u32x4*)(vsrc + (size_t)(NT - 2) * 64 * 64); float fr1 = (tid < 64) ? F2[(NT - 2) * 64 + tid] : 0.f;
    float m = 0.f, l = 0.f, fqm = Fq; f32x16 o0 = {}, o1 = {}; bool first = true;
    const int vlane = (4 * hi + ((lane & 15) >> 2)) * 64 + ((lane >> 4) & 1) * 32 + (lane & 3) * 8;
    __syncthreads();
    *(LAS u32x4*)(lds + lkey * 144 + lch * 16) = kr0;
    *(LAS u32x4*)(lds + 9216 + (lch >> 2) * 4096 + lkey * 64 + (lch & 3) * 16) = vr0;
    if (tid < 64) *(LAS float*)(lds + 17408 + tid * 4) = fr0;
    __syncthreads();
#define FOX_STEP(it_, KN, VN, FN, KW, VW, FW) do { const int it = (it_); const int t = NT - 1 - it; LAS unsigned char* buf = lds + (it & 1) * FB; LAS unsigned char* nbuf = lds + ((it & 1) ^ 1) * FB; \
        if (it + 2 < NT) { KN = *(const u32x4*)(ksrc + (size_t)(t - 2) * 64 * 64); VN = *(const u32x4*)(vsrc + (size_t)(t - 2) * 64 * 64); if (tid < 64) FN = F2[(t - 2) * 64 + tid]; } \
        if (t * 64 <= wlast) { \
            bf16x8 kf[2][4]; f32x16 s[2]; \
            _Pragma("unroll") for (int kk = 0; kk < 2; ++kk) _Pragma("unroll") for (int d0 = 0; d0 < 4; ++d0) kf[kk][d0] = *(const LAS bf16x8*)(buf + (kk * 32 + r32) * 144 + d0 * 32 + hi * 16); \
            const LAS float* Ft = (const LAS float*)(buf + 17408); \
            _Pragma("unroll") for (int kk = 0; kk < 2; ++kk) _Pragma("unroll") for (int g = 0; g < 4; ++g) { const f32x4 fk = *(const LAS f32x4*)(Ft + kk * 32 + 8 * g + 4 * hi); \
                _Pragma("unroll") for (int e = 0; e < 4; ++e) s[kk][4 * g + e] = fqm - fk[e]; } \
            if (t * 64 + 63 > wfirst) { \
                _Pragma("unroll") for (int kk = 0; kk < 2; ++kk) _Pragma("unroll") for (int r = 0; r < 16; ++r) if (t * 64 + kk * 32 + crow(r, hi) > qrow) s[kk][r] = -INFINITY; } \
            attn_qk<2>(kf, qr, s); attn_sm<2>(s, buf + 9216 + vlane, 4096, first, m, l, o0, o1); \
            first = false; fqm = Fq - m; } \
        if (it + 1 < NT) { \
            *(LAS u32x4*)(nbuf + lkey * 144 + lch * 16) = KW; \
            *(LAS u32x4*)(nbuf + 9216 + (lch >> 2) * 4096 + lkey * 64 + (lch & 3) * 16) = VW; \
            if (tid < 64) *(LAS float*)(nbuf + 17408 + tid * 4) = FW; } \
        __syncthreads(); } while (0)
#pragma unroll 1
    for (int it2 = 0; it2 < NT; it2 += 2) {
        FOX_STEP(it2, kr0, vr0, fr0, kr1, vr1, fr1);
        FOX_STEP(it2 + 1, kr1, vr1, fr1, kr0, vr0, fr0);
    }
#undef FOX_STEP
    const float rl = 1.0f / hsum2(l);
    bf16_t* op = YB + tok * 512 + h * 128;
#pragma unroll
    for (int g = 0; g < 4; ++g) {
        u32x2 w0 = {cvtpk(o0[4 * g] * rl, o0[4 * g + 1] * rl), cvtpk(o0[4 * g + 2] * rl, o0[4 * g + 3] * rl)};
        u32x2 w1 = {cvtpk(o1[4 * g] * rl, o1[4 * g + 1] * rl), cvtpk(o1[4 * g + 2] * rl, o1[4 * g + 3] * rl)};
        *(u32x2*)(op + 8 * g + 4 * hi) = w0; *(u32x2*)(op + 32 + 8 * g + 4 * hi) = w1;
    }
}

__device__ __forceinline__ void dil_item(KArgs a, LAS unsigned char* lds, int item, int tid, int lane, int wid) {
    const bf16_t* Z = (const bf16_t*)(a->ws + WS_Z); bf16_t* YA = (bf16_t*)(a->ws + WS_Y);
    unsigned char* tmpb = a->ws + WS_H + (size_t)blockIdx.x * (3 * 512 * 64 * 2 + 3 * 512 * 4);
    bf16_t* TO = (bf16_t*)tmpb; float* TL = (float*)(tmpb + 3 * 512 * 64 * 2);
    const int b = item >> 5, slot = (item >> 3) & 3, s0 = (item & 7) * 512;
    const int r32 = lane & 31, hi = lane >> 5;
    LAS unsigned char* vbuf = lds + wid * 4096;
    const LAS unsigned char* vb0 = vbuf + (4 * hi + ((lane & 15) >> 2)) * 64 + ((lane >> 4) & 1) * 32 + (lane & 3) * 8;
    __syncthreads();
#pragma unroll 1
    for (int g = 0; g < 3; ++g) {
        const int sh = 2 * g, d = 1 << sh, head = 4 * g + slot;
        const float slope2 = exp2f(-8.0f * (float)(head + 1) / 12.0f) * (float)d * LOG2E;
#pragma unroll 1
        for (int j = 0; j < 2; ++j) {
            const int sub = wid * 2 + j, spc = 16 >> sh, cls = sub / spc, lsub = sub % spc;
            const int l0 = (s0 >> sh) + lsub * 32;
            const size_t hb = ((size_t)(b * 12 + head) * SEQ + (size_t)cls * (SEQ >> sh)) * 64;
            const int tl = (l0 + r32) * d + cls - s0;
            bf16x8 qr[4];
            { const bf16_t* qp = Z + ZO_QA + hb + (size_t)(l0 + r32) * 64 + hi * 8;
#pragma unroll
              for (int d0 = 0; d0 < 4; ++d0) qr[d0] = *(const bf16x8*)(qp + d0 * 16); }
            float m = 0.f, l = 0.f; f32x16 o0 = {}, o1 = {};
            const int cstart = (l0 >= 128) ? 0 : ((128 - l0) >> 5);
            bf16x8 kA[1][4], kB[1][4]; u32x4 vA[4], vB[4];
            const bf16_t* kbase = Z + ZO_KA + hb + (size_t)(l0 - 128 + r32) * 64 + hi * 8;
            const bf16_t* vbase = Z + ZO_VA + hb + (size_t)(l0 - 128 + (lane >> 3)) * 64 + (lane & 7) * 8;
            const float sl4 = slope2 * (float)(4 * hi);
#define DIL_LOADK(KF, c) do { if ((c) >= cstart) { _Pragma("unroll") for (int d0 = 0; d0 < 4; ++d0) KF[0][d0] = *(const bf16x8*)(kbase + (c) * 2048 + d0 * 16); } } while (0)
#define DIL_LOADV(VR, c) do { if ((c) >= cstart) { _Pragma("unroll") for (int i = 0; i < 4; ++i) VR[i] = *(const u32x4*)(vbase + (c) * 2048 + i * 512); } } while (0)
#define DIL_STEP(KF, VR, c) do { if ((c) >= cstart) { \
                _Pragma("unroll") for (int i = 0; i < 4; ++i) { const int idx = i * 64 + lane, kv = idx >> 3, ch = idx & 7; *(LAS u32x4*)(vbuf + (ch >> 2) * 2048 + kv * 64 + (ch & 3) * 16) = VR[i]; } \
                if ((c) >= 2) DIL_LOADV(VR, (c) - 2); \
                f32x16 s[1]; const float t1 = sl4 - slope2 * (float)(128 + r32 - 32 * (c)) - m;        \
                _Pragma("unroll") for (int r = 0; r < 16; ++r) { const int kc_ = (r & 3) + 8 * (r >> 2); float v_ = slope2 * (float)kc_ + t1; \
                    if ((c) == 4) { if (kc_ + 4 * hi > r32) v_ = -INFINITY; } \
                    if ((c) == 0) { if (kc_ + 4 * hi < r32) v_ = -INFINITY; } \
                    s[0][r] = v_; } \
                attn_qk<1>(KF, qr, s); \
                if ((c) >= 2) DIL_LOADK(KF, (c) - 2); \
                attn_sm<1>(s, vb0, 2048, (c) == 4, m, l, o0, o1); } } while (0)
            DIL_LOADK(kA, 4); DIL_LOADV(vA, 4); DIL_LOADK(kB, 3); DIL_LOADV(vB, 3);
            DIL_STEP(kA, vA, 4);
            DIL_STEP(kB, vB, 3);
            DIL_STEP(kA, vA, 2);
            DIL_STEP(kB, vB, 1);
            DIL_STEP(kA, vA, 0);
#undef DIL_STEP
#undef DIL_LOADK
#define DIL_LOAD DIL_LOADV
#undef DIL_LOAD
            l = hsum2(l);
            const float rl = 1.0f / l;
            bf16_t* op = TO + ((size_t)g * 512 + tl) * 64;
#pragma unroll
            for (int gg = 0; gg < 4; ++gg) {
                u32x2 w0 = {cvtpk(o0[4 * gg] * rl, o0[4 * gg + 1] * rl), cvtpk(o0[4 * gg + 2] * rl, o0[4 * gg + 3] * rl)};
                u32x2 w1 = {cvtpk(o1[4 * gg] * rl, o1[4 * gg + 1] * rl), cvtpk(o1[4 * gg + 2] * rl, o1[4 * gg + 3] * rl)};
                *(u32x2*)(op + 8 * gg + 4 * hi) = w0; *(u32x2*)(op + 32 + 8 * gg + 4 * hi) = w1;
            }
            if (hi == 0) TL[g * 512 + tl] = m + __builtin_amdgcn_logf(l);
        }
    }
    __threadfence_block();
    __syncthreads();
    {
        const float e0 = TL[tid], e1 = TL[512 + tid], e2 = TL[1024 + tid];
        const float mx = fmaxf(e0, fmaxf(e1, e2));
        float w0 = __builtin_amdgcn_exp2f(e0 - mx), w1 = __builtin_amdgcn_exp2f(e1 - mx), w2 = __builtin_amdgcn_exp2f(e2 - mx);
        const float rs = 1.0f / (w0 + w1 + w2); w0 *= rs; w1 *= rs; w2 *= rs;
        const u32x4* p0 = (const u32x4*)(TO + (size_t)tid * 64); const u32x4* p1 = (const u32x4*)(TO + ((size_t)512 + tid) * 64); const u32x4* p2 = (const u32x4*)(TO + ((size_t)1024 + tid) * 64);
        u32x4* yo = (u32x4*)(YA + ((size_t)b * SEQ + s0 + tid) * 512 + slot * 128);
#pragma unroll
        for (int i = 0; i < 8; ++i) { const u32x4 x0 = p0[i], x1 = p1[i], x2 = p2[i]; u32x4 y;
#pragma unroll
            for (int e = 0; e < 4; ++e) y[e] = cvtpk(w0 * bf_lo(x0[e]) + w1 * bf_lo(x1[e]) + w2 * bf_lo(x2[e]), w0 * bf_hi(x0[e]) + w1 * bf_hi(x1[e]) + w2 * bf_hi(x2[e]));
            yo[i] = y; }
    }
    __syncthreads();
}

__device__ __forceinline__ void phase_attn(KArgs a, LAS unsigned char* lds, int tid, int lane, int wid) {
    const int G = gridDim.x, bx = blockIdx.x; const int vcu = (G % 8 == 0) ? (bx % 8) * (G / 8) + bx / 8 : bx;
    for (int item = vcu; item < 256; item += G) {
        dil_item(a, lds, item, tid, lane, wid);
        const int bh = item >> 3, s = item & 7;
        fox_unit(a, lds, bh >> 2, bh & 3, s, tid, lane, wid);
        fox_unit(a, lds, bh >> 2, bh & 3, 15 - s, tid, lane, wid);
    }
}

#define XB_TMO      128
#define XB_XCNT(j)  (256  + 64 * (j))
#define XB_XSUB(j)  (1280 + 64 * (j))
#define XB_XGEN(j)  (2304 + 64 * (j))
#define XB_TOP      3328
#define XB_TOPGEN   3392
#define XCD_BAR_WORDS 3456
#define XB_SPIN_CAP (1u << 18)
__device__ __forceinline__ unsigned xb_ld(unsigned* p)              { return __hip_atomic_load(p, __ATOMIC_RELAXED, __HIP_MEMORY_SCOPE_AGENT); }
__device__ __forceinline__ unsigned xb_add(unsigned* p, unsigned v) { return __hip_atomic_fetch_add(p, v, __ATOMIC_RELAXED, __HIP_MEMORY_SCOPE_AGENT); }
__device__ __forceinline__ unsigned xb_xcc_id() { return (unsigned)__builtin_amdgcn_s_getreg((3 << 11) | 20) & 0xFu; }
#define XB_SPIN(cond, bar) do { unsigned _sp = 0; while (cond) { __builtin_amdgcn_s_sleep(1); \
    if ((++_sp & 255u) == 0u) { if (xb_ld(&(bar)[XB_TMO])) break; if (_sp > XB_SPIN_CAP) { atomicAdd(&(bar)[XB_TMO], 1u); break; } } } } while (0)
struct XcdBarrier { unsigned* bar; unsigned x; volatile LAS unsigned* st; };
__device__ __forceinline__ XcdBarrier xcd_barrier_post(unsigned* bar, volatile LAS unsigned* st) {
    XcdBarrier b; b.bar = bar; b.x = xb_xcc_id(); b.st = st;
    if (threadIdx.x == 0) (void)xb_add(&bar[XB_XCNT(b.x)], 1u);
    return b;
}
__device__ __forceinline__ void xcd_barrier_complete(unsigned* bar, unsigned x, unsigned& nloc, unsigned& nx) {
    const unsigned G = gridDim.x * gridDim.y * gridDim.z;
    unsigned sum, cnt, mine, sp = 0u;
    for (;;) {
        sum = 0u; cnt = 0u; mine = 0u;
#pragma unroll
        for (unsigned j = 0; j < 16; ++j) { const unsigned c = xb_ld(&bar[XB_XCNT(j)]); sum += c; cnt += (c > 0u) ? 1u : 0u; mine = (j == x) ? c : mine; }
        if (sum == G) break;
        __builtin_amdgcn_s_sleep(1);
        if ((++sp & 255u) == 0u) { if (xb_ld(&bar[XB_TMO])) break; if (sp > XB_SPIN_CAP) { atomicAdd(&bar[XB_TMO], 1u); break; } }
    }
    nloc = mine > 0u ? mine : 1u; nx = cnt > 0u ? cnt : 1u;
}
__device__ __forceinline__ void xcd_barrier(const XcdBarrier& b, const int tid0) {
    asm volatile("s_waitcnt vmcnt(0)" ::: "memory");
    __syncthreads();
    if (tid0 == 0) {
        unsigned* bar = b.bar;
        __builtin_amdgcn_s_waitcnt(0);
        unsigned nloc = b.st[0], nx = b.st[1];
        if (nloc == 0u) { xcd_barrier_complete(bar, b.x, nloc, nx); b.st[0] = nloc; b.st[1] = nx; }
        const unsigned old = xb_add(&bar[XB_XSUB(b.x)], 1u);
        const unsigned gen = old / nloc;
        if (old + 1u == (gen + 1u) * nloc) {
            __builtin_amdgcn_fence(__ATOMIC_RELEASE, "agent");
            asm volatile("s_waitcnt vmcnt(0)" ::: "memory");
            (void)xb_add(&bar[XB_TOP], 1u);
        }
        XB_SPIN(xb_ld(&bar[XB_TOP]) < nx * (gen + 1u), bar);
        __builtin_amdgcn_fence(__ATOMIC_ACQUIRE, "agent");
        asm volatile("s_waitcnt vmcnt(0)" ::: "memory");
    }
    __syncthreads();
}

__global__ void __launch_bounds__(512, 2) mk_fwd(Args karg) {
    extern __shared__ __attribute__((aligned(16))) unsigned char lds_raw[];
    LAS unsigned char* lds = (LAS unsigned char*)lds_raw;
    const int G = gridDim.x, bx = blockIdx.x;
    const int ph_lo = karg.ph_lo, ph_hi = karg.ph_hi;
    const int wid0 = __builtin_amdgcn_readfirstlane((int)threadIdx.x >> 6);
    if (threadIdx.x < 2) ((LAS unsigned*)(lds + LDS_MISC))[16 + threadIdx.x] = 0u;
    __syncthreads();
    const XcdBarrier bar = xcd_barrier_post((unsigned*)(karg.ws + WS_CTL), (volatile LAS unsigned*)(lds + LDS_MISC) + 16);
#pragma unroll 1
    for (int ph = ph_lo; ph < ph_hi; ++ph) {
        if (ph_hi > 1000) cg::this_grid().sync();
        if (ph > ph_lo) xcd_barrier(bar, (wid0 << 6) | (int)__builtin_amdgcn_mbcnt_hi(~0u, __builtin_amdgcn_mbcnt_lo(~0u, 0u)));
        KArgs a = (KArgs)__builtin_amdgcn_kernarg_segment_ptr(); asm volatile("" : "+s"(a));
#define MK_TID() int tid = (wid0 << 6) | (int)__builtin_amdgcn_mbcnt_hi(~0u, __builtin_amdgcn_mbcnt_lo(~0u, 0u)); asm volatile("" : "+v"(tid)); const int lane = tid & 63, wid = wid0
        unsigned char* ws = a->ws;
        bf16_t* H = (bf16_t*)(ws + WS_H); bf16_t* Zb = (bf16_t*)(ws + WS_Z); bf16_t* Y = (bf16_t*)(ws + WS_Y);
        if (ph == 0) { MK_TID(); phase_prologue(a, lds, tid, lane, wid); continue; }
        if (ph == NPHASE - 1) { MK_TID(); phase_norm<3>(a, 0, lds, tid, lane, wid); continue; }
        const int l = (ph - 1) / 8, sp = (ph - 1) % 8;
        if (sp == 0) { MK_TID(); phase_norm<1>(a, l, lds, tid, lane, wid); continue; }
        if (sp == 5) { MK_TID(); phase_norm<2>(a, l, lds, tid, lane, wid); continue; }
        if (sp == 2) { MK_TID(); phase_attn(a, lds, tid, lane, wid); continue; }
        if (sp == 1) { MK_TID(); phase_scan(a, lds, tid, lane, wid); }
        const unsigned char* wl = ws + WS_W + (size_t)l * W_LAYER;
        const float* modl = (const float*)(ws + WS_MOD) + (size_t)l * 8 * NMODC;
        pg8::Gemm g; EpiAny E; int N;
        g.M = T_TOK; g.zskip = 0; E.g = nullptr; E.src = nullptr;
        switch (sp) {
        case 1: g.A = H; g.Bt = (const bf16_t*)(wl + WO_IN); N = ZP; g.K = DM; E.mode = 0; E.dst = Zb; break;
        case 3: g.A = Y; g.Bt = (const bf16_t*)(wl + WO_UP); N = 2 * DM; g.K = 512; g.zskip = 1; E.mode = 1; E.src = Zb + ZO_G; E.dst = H; break;
        case 4: g.A = H; g.Bt = (const bf16_t*)(wl + WO_OUT); N = DM; g.K = DM; E.mode = 3; E.src = (l == 0) ? (const void*)a->in[0] : (const void*)a->out; E.dst = a->out; E.g = modl + 2 * DM; break;
        case 6: g.A = H; g.Bt = (const bf16_t*)(wl + WO_FFI); N = 2 * DFF; g.K = DM; E.mode = 4; E.dst = Zb; break;
        default: g.A = Zb; g.Bt = (const bf16_t*)(wl + WO_FFO); N = DM; g.K = DFF; E.mode = 3; E.src = a->out; E.dst = a->out; E.g = modl + 5 * DM; break;
        }
        g.N = N;
        pg8::StaticOrder S; S.init(T_TOK, N, G, bx, sp == 1 ? 12 : 0);
        if (sp == 3) { MK_TID(); (void)lane; (void)wid; EpiUpOnly EU{Zb + ZO_G, H}; pg8::gemm_phase<EpiUpOnly, pg8::StaticOrder, true, true, true>(lds, g, S, EU, tid); }
        else { MK_TID(); (void)lane; (void)wid; pg8::gemm_phase<EpiAny, pg8::StaticOrder, true, true, false>(lds, g, S, E, tid); }
    }
}

extern "C" void kernel_launch(void* const* d_in, const int* in_sizes, int n_in, void* d_out, int out_size, void* d_ws, size_t ws_size, hipStream_t stream) {
    static int grid = 0;
    if (grid == 0) {
        if (n_in != 14 || in_sizes[0] != T_TOK * DM || out_size != T_TOK * DM || ws_size < WS_END) { fprintf(stderr, "kernel_launch: unexpected shapes / workspace (n_in %d, ws %zu)\n", n_in, ws_size); grid = -1; return; }
        int dev = 0, cus = 0, per_cu = 0;
        if (hipGetDevice(&dev) != hipSuccess || hipDeviceGetAttribute(&cus, hipDeviceAttributeMultiprocessorCount, dev) != hipSuccess) { grid = -1; return; }
        if (hipFuncSetAttribute((const void*)mk_fwd, hipFuncAttributeMaxDynamicSharedMemorySize, LDS_BYTES) != hipSuccess) { fprintf(stderr, "kernel_launch: hipFuncSetAttribute failed\n"); grid = -1; return; }
        if (hipOccupancyMaxActiveBlocksPerMultiprocessor(&per_cu, (const void*)mk_fwd, 512, LDS_BYTES) != hipSuccess || per_cu < 1) { fprintf(stderr, "kernel_launch: occupancy query failed (%d)\n", per_cu); (void)hipGetLastError(); grid = -1; return; }
        grid = cus * 1;
    }
    if (grid < 0) return;
    if (hipMemsetAsync((char*)d_ws + WS_CTL, 0, CTL_BYTES, stream) != hipSuccess) { fprintf(stderr, "kernel_launch: memset of barrier words failed\n"); return; }
    Args a{};
    for (int i = 0; i < 14; ++i) a.in[i] = (const float*)d_in[i];
    a.out = (float*)d_out; a.ws = (unsigned char*)d_ws;
#if MK_MULTI
    for (int ph = 0; ph < NPHASE; ++ph) { a.ph_lo = ph; a.ph_hi = ph + 1; hipLaunchKernelGGL(mk_fwd, dim3(grid), dim3(512), LDS_BYTES, stream, a); }
#else
    a.ph_lo = 0; a.ph_hi = NPHASE;
    void* args[] = {&a};
    hipError_t e = hipLaunchCooperativeKernel((void*)mk_fwd, dim3(grid), dim3(512), args, LDS_BYTES, stream);
    if (e != hipSuccess) fprintf(stderr, "cooperative launch failed: %s (grid %d)\n", hipGetErrorString(e), grid);
#endif
}
```

```cpp
#include <hip/hip_runtime.h>
#include <hip/hip_cooperative_groups.h>
#include <cstdio>
#include <cstdint>
namespace cg = cooperative_groups;

#ifndef MK_MULTI
#define MK_MULTI 0
#endif

#define LAS __attribute__((address_space(3)))
typedef unsigned short bf16_t;
typedef short bf16x8 __attribute__((ext_vector_type(8)));
typedef short s16x4 __attribute__((ext_vector_type(4)));
typedef float f32x4 __attribute__((ext_vector_type(4)));
typedef float f32x2 __attribute__((ext_vector_type(2)));
typedef float f32x16 __attribute__((ext_vector_type(16)));
typedef unsigned u32x4 __attribute__((ext_vector_type(4)));
typedef unsigned u32x2 __attribute__((ext_vector_type(2)));
typedef __bf16 bf16x2_t __attribute__((ext_vector_type(2)));

__device__ __forceinline__ unsigned cvtpk(float lo, float hi) { f32x2 v = {lo, hi}; bf16x2_t b = __builtin_convertvector(v, bf16x2_t); return __builtin_bit_cast(unsigned, b); }
__device__ __forceinline__ float bf_lo(unsigned w) { return __uint_as_float(w << 16); }
__device__ __forceinline__ float bf_hi(unsigned w) { return __uint_as_float(w & 0xffff0000u); }
__device__ __forceinline__ float sigmoidf_fast(float x) { return __builtin_amdgcn_rcpf(1.0f + __builtin_amdgcn_exp2f(-1.4426950408889634f * x)); }

namespace pg8 {
constexpr int BM = 256, BK = 64, HALF = 128, HTB = HALF * BK * 2, STAGE_BYTES = 8 * HTB, NXCD = 8, WGM = 8;
__host__ __device__ __forceinline__ int lds_byte(int r, int c) { const int st = (r >> 4) * 2 + (c >> 5), rr = r & 15, cc = c & 31, ob = rr * 64 + cc * 2; return st * 1024 + (ob ^ (((ob >> 9) & 1) << 5)); }
__host__ __device__ __forceinline__ void stage_rc(int b, int& R, int& C) { const int st = b / 1024, sb = b % 1024, swz = sb ^ (((sb >> 9) & 1) << 5); R = (st >> 1) * 16 + swz / 64; C = (st & 1) * 32 + (swz % 64) / 2; }
__host__ __device__ __forceinline__ int perm32(int rho) { const int n = rho >> 4, i = rho & 15; return 8 * (i >> 2) + 4 * n + (i & 3); }
struct Unit { int pm, pn; };
struct Gemm { const bf16_t* A; const bf16_t* Bt; int M, N, K; int zskip; };
struct StaticOrder {
    int nM, nN, nwg, G, c, rot;
    __host__ __device__ void init(int M, int N, int G_, int c_, int rot_ = 0) { nM = M / BM; nN = N / BM; nwg = nM * nN; G = G_; c = c_; rot = rot_; }
    __host__ __device__ bool next(int i, Unit& u) const {
        const long L = (long)i * G + c; if (L >= nwg) return false;
        int wgid = (int)L; { const int q = nwg / NXCD, r = nwg % NXCD, xcd = wgid % NXCD, off = wgid / NXCD; wgid = (xcd < r ? xcd * (q + 1) : r * (q + 1) + (xcd - r) * q) + off; }
        const int nig = WGM * nN, gid = wgid / nig, fm = gid * WGM, gsz = (nM - fm) < WGM ? (nM - fm) : WGM;
        u.pm = fm + ((wgid % nig) % gsz); u.pn = (wgid % nig) / gsz + rot; if (u.pn >= nN) u.pn -= nN; return true;
    }
    __device__ __forceinline__ void a_ready(const Unit&) const {}
    __device__ __forceinline__ void done(const Unit&) const {}
};

template <class Epi, class Sched, bool ALIGN_EPI = false, bool SP2 = false, bool ZSKIP = false>
__device__ __forceinline__ void gemm_phase(LAS unsigned char* lds, const Gemm g, const Sched& S, const Epi& E, const int tid) {
    const int wid = __builtin_amdgcn_readfirstlane(tid >> 6), lane = tid & 63, wr = wid >> 2, wc = wid & 3, fr = lane & 15, fq = lane >> 4;
    const int K = g.K, nt = K / BK;
    unsigned voffA[2], voffB[2];
#pragma unroll
    for (int i = 0; i < 2; ++i) { int R, C; stage_rc(tid * 16 + i * 8192, R, C); const int Rb = Epi::PERM ? ((R & ~31) + perm32(R & 31)) : R;
        voffA[i] = (unsigned)(R * K + C) * 2u; voffB[i] = (unsigned)(Rb * K + C) * 2u; }
    const size_t kstep = (size_t)(BK * 2);
    const size_t hstep = (size_t)HALF * K * 2;
    const size_t tstep = 2 * hstep;
    const unsigned ldsw = (unsigned)wid * 1024u;
    const int aoff = lds_byte(wr * 64 + fr, fq * 8), boff = lds_byte(wc * 32 + fr, fq * 8);
#define PG8_SA(b, h) (((b) * 2 + (h)) * HTB)
#define PG8_SB(b, h) ((4 + (b) * 2 + (h)) * HTB)
#define PG8_STAGE(bufoff, gbase, voff) do { _Pragma("unroll") for (int _i = 0; _i < 2; ++_i) \
        __builtin_amdgcn_global_load_lds((const unsigned*)((const char*)(gbase) + (voff)[_i]), (LAS unsigned*)(lds + (bufoff) + ldsw + _i * 8192), 16, 0, 0); } while (0)
#define PG8_LDA(dst, b, h) do { _Pragma("unroll") for (int m = 0; m < 4; ++m) _Pragma("unroll") for (int k = 0; k < 2; ++k) dst[m][k] = *(const LAS bf16x8*)(lds + PG8_SA(b, h) + aoff + m * 2048 + k * 1024); } while (0)
#define PG8_LDB(dst, b, h) do { _Pragma("unroll") for (int n = 0; n < 2; ++n) _Pragma("unroll") for (int k = 0; k < 2; ++k) dst[n][k] = *(const LAS bf16x8*)(lds + PG8_SB(b, h) + boff + n * 2048 + k * 1024); } while (0)
#define PG8_MMA(ai, bj, At, Bt) do { __builtin_amdgcn_s_setprio(1); _Pragma("unroll") for (int m = 0; m < 4; ++m) _Pragma("unroll") for (int n = 0; n < 2; ++n) _Pragma("unroll") for (int k = 0; k < 2; ++k) \
        acc[ai][bj][m][n] = __builtin_amdgcn_mfma_f32_16x16x32_bf16(Bt[n][k], At[m][k], acc[ai][bj][m][n], 0, 0, 0); __builtin_amdgcn_s_setprio(0); } while (0)
#define PG8_WAIT_V(n) asm volatile("s_waitcnt vmcnt(" #n ")" ::: "memory")
#define PG8_WAIT_L(n) asm volatile("s_waitcnt lgkmcnt(" #n ")" ::: "memory")
#define PG8_BAR __builtin_amdgcn_s_barrier()
#define PG8_SCHED __builtin_amdgcn_sched_barrier(0)
    Unit cur, nxt; int ui = 0;
    if (!S.next(0, cur)) return;
    f32x4 acc[2][2][4][2];
#pragma unroll
    for (int a = 0; a < 2; ++a)
#pragma unroll
        for (int b = 0; b < 2; ++b)
#pragma unroll
            for (int m = 0; m < 4; ++m)
#pragma unroll
                for (int n = 0; n < 2; ++n) acc[a][b][m][n] = (f32x4){0.f, 0.f, 0.f, 0.f};
    bf16x8 At[4][2], B0[2][2], B1[2][2];
    const char* cA = (const char*)g.A + (size_t)cur.pm * tstep; const char* cB = (const char*)g.Bt + (size_t)cur.pn * tstep;
    S.a_ready(cur);
    if constexpr (SP2) {
        PG8_STAGE(PG8_SB(0, 0), cB, voffB); PG8_STAGE(PG8_SB(0, 1), cB + hstep, voffB); PG8_STAGE(PG8_SA(0, 0), cA, voffA); PG8_STAGE(PG8_SA(0, 1), cA + hstep, voffA);
        if (wr == 1) PG8_BAR;
        PG8_WAIT_V(2); PG8_BAR;
        PG8_STAGE(PG8_SB(1, 0), cB + kstep, voffB); PG8_STAGE(PG8_SA(1, 0), cA + kstep, voffA); PG8_STAGE(PG8_SB(1, 1), cB + hstep + kstep, voffB);
        PG8_WAIT_V(6); PG8_BAR;
    } else {
        PG8_STAGE(PG8_SB(0, 0), cB, voffB); PG8_STAGE(PG8_SA(0, 0), cA, voffA); PG8_STAGE(PG8_SB(0, 1), cB + hstep, voffB); PG8_STAGE(PG8_SA(0, 1), cA + hstep, voffA);
        if (wr == 1) PG8_BAR;
        PG8_WAIT_V(4); PG8_BAR;
        PG8_STAGE(PG8_SB(1, 0), cB + kstep, voffB); PG8_STAGE(PG8_SA(1, 0), cA + kstep, voffA); PG8_STAGE(PG8_SB(1, 1), cB + hstep + kstep, voffB);
        PG8_WAIT_V(6); PG8_BAR;
    }
    for (;;) {
        const bool has_next = S.next(ui + 1, nxt);
        const char* nA = has_next ? (const char*)g.A + (size_t)nxt.pm * tstep : cA; const char* nB = has_next ? (const char*)g.Bt + (size_t)nxt.pn * tstep : cB;
        for (int t = 0; t < nt; t += 2) {
            const bool last = (t == nt - 2); const int zb = (2 * t >= nt) ? 1 : 0;
            const char* a1 = cA + (size_t)(t + 1) * kstep;
            const char* a2 = last ? nA : cA + (size_t)(t + 2) * kstep; const char* b2 = last ? nB : cB + (size_t)(t + 2) * kstep;
            const char* a3 = a2 + kstep; const char* b3 = b2 + kstep;
            if (last && has_next) S.a_ready(nxt);
            if constexpr (SP2) {
            PG8_LDB(B0, 0, 0); PG8_LDB(B1, 0, 1); PG8_SCHED; PG8_LDA(At, 0, 0); PG8_STAGE(PG8_SA(1, 1), a1 + hstep, voffA);
            PG8_WAIT_V(8); PG8_WAIT_L(0); PG8_BAR; PG8_MMA(0, 0, At, B0); if constexpr (!ZSKIP) PG8_MMA(0, 1, At, B1); PG8_BAR; PG8_SCHED;
            PG8_LDA(At, 0, 1); PG8_STAGE(PG8_SB(0, 0), b2, voffB); PG8_STAGE(PG8_SB(0, 1), b2 + hstep, voffB); PG8_STAGE(PG8_SA(0, 0), a2, voffA);
            PG8_WAIT_V(8); PG8_WAIT_L(0); PG8_BAR; PG8_MMA(1, 0, At, B0); if constexpr (!ZSKIP) PG8_MMA(1, 1, At, B1); PG8_BAR; PG8_SCHED;
            PG8_LDB(B0, 1, 0); PG8_LDB(B1, 1, 1); PG8_SCHED; PG8_LDA(At, 1, 0); PG8_STAGE(PG8_SA(0, 1), a2 + hstep, voffA);
            PG8_WAIT_V(8); PG8_WAIT_L(0); PG8_BAR; if constexpr (!ZSKIP) PG8_MMA(0, 0, At, B0); PG8_MMA(0, 1, At, B1); PG8_BAR; PG8_SCHED;
            PG8_LDA(At, 1, 1); PG8_STAGE(PG8_SB(1, 0), b3, voffB); PG8_STAGE(PG8_SB(1, 1), b3 + hstep, voffB); PG8_STAGE(PG8_SA(1, 0), a3, voffA);
            PG8_WAIT_V(8); PG8_WAIT_L(0); PG8_BAR; if constexpr (!ZSKIP) PG8_MMA(1, 0, At, B0); PG8_MMA(1, 1, At, B1); PG8_BAR; PG8_SCHED;
            } else {
            PG8_LDB(B0, 0, 0); PG8_SCHED; PG8_LDA(At, 0, 0); PG8_STAGE(PG8_SA(1, 1), a1 + hstep, voffA);
            PG8_WAIT_L(8); PG8_BAR; PG8_WAIT_L(0); PG8_MMA(0, 0, At, B0); PG8_BAR; PG8_SCHED;
            PG8_LDB(B1, 0, 1); PG8_STAGE(PG8_SB(0, 0), b2, voffB);
            PG8_BAR; PG8_WAIT_L(0); PG8_MMA(0, 1, At, B1); PG8_BAR;
            PG8_LDA(At, 0, 1); PG8_STAGE(PG8_SA(0, 0), a2, voffA);
            PG8_BAR; PG8_WAIT_L(0); PG8_MMA(1, 0, At, B0); PG8_BAR; PG8_SCHED;
            PG8_STAGE(PG8_SB(0, 1), b2 + hstep, voffB);
            PG8_WAIT_V(6); PG8_BAR; PG8_MMA(1, 1, At, B1); PG8_BAR;
            PG8_LDB(B0, 1, 0); PG8_SCHED; PG8_LDA(At, 1, 0); PG8_STAGE(PG8_SA(0, 1), a2 + hstep, voffA);
            PG8_WAIT_L(8); PG8_BAR; PG8_WAIT_L(0); PG8_MMA(0, 0, At, B0); PG8_BAR; PG8_SCHED;
            PG8_LDB(B1, 1, 1); PG8_STAGE(PG8_SB(1, 0), b3, voffB);
            PG8_BAR; PG8_WAIT_L(0); PG8_MMA(0, 1, At, B1); PG8_BAR;
            PG8_LDA(At, 1, 1); PG8_STAGE(PG8_SA(1, 0), a3, voffA);
            PG8_BAR; PG8_WAIT_L(0); PG8_MMA(1, 0, At, B0); PG8_BAR; PG8_SCHED;
            PG8_STAGE(PG8_SB(1, 1), b3 + hstep, voffB);
            PG8_WAIT_V(6); PG8_BAR; PG8_MMA(1, 1, At, B1); PG8_BAR;
            }
        }
        if constexpr (ALIGN_EPI) { if (wr == 0) PG8_BAR; }
        E(acc, cur, wr, wc, fr, fq); S.done(cur);
        if (!has_next) break;
#pragma unroll
        for (int a = 0; a < 2; ++a)
#pragma unroll
            for (int b = 0; b < 2; ++b)
#pragma unroll
                for (int m = 0; m < 4; ++m)
#pragma unroll
                    for (int n = 0; n < 2; ++n) acc[a][b][m][n] = (f32x4){0.f, 0.f, 0.f, 0.f};
        cur = nxt; cA = nA; cB = nB; ++ui;
        if constexpr (ALIGN_EPI) { if (wr == 1) PG8_BAR; }
    }
    PG8_WAIT_V(0);
    if constexpr (!ALIGN_EPI) { if (wr == 0) PG8_BAR; }
    PG8_BAR;
#undef PG8_SA
#undef PG8_SB
#undef PG8_STAGE
#undef PG8_LDA
#undef PG8_LDB
#undef PG8_MMA
#undef PG8_WAIT_V
#undef PG8_WAIT_L
#undef PG8_BAR
#undef PG8_SCHED
}
}

constexpr int T_TOK = 32768, DM = 1024, SEQ = 4096, NBATCH = 8, DIN = 5124, ZP = 5120, DFF = 2816, NMODC = 6144;
constexpr int GP = 2048;
constexpr size_t HM_A = (size_t)8 * 12 * 4096 * 64, HM_B = (size_t)8 * 4 * 4096 * 64;
constexpr size_t ZO_G = 0, ZO_QA = (size_t)T_TOK * GP, ZO_KA = ZO_QA + HM_A, ZO_VA = ZO_KA + HM_A, ZO_QB = ZO_VA + HM_A, ZO_KB = ZO_QB + HM_B, ZO_VB = ZO_KB + HM_B;
constexpr float LOG2E = 1.4426950408889634f;
constexpr float C2 = 0.125f * LOG2E;
constexpr size_t MiB = 1u << 20;
constexpr size_t WS_MOD = 0, WS_LOGF = 512 * 1024, WS_F2 = 1 * MiB, WS_CTL = 1536 * 1024, CTL_BYTES = 16384, WS_W = 2 * MiB, W_LAYER = 32 * MiB;
constexpr size_t WO_IN = 0, WO_OUT = 11534336, WO_FFI = 13631488, WO_FFO = 25165824, WO_UP = 30932992;
constexpr size_t WS_H = 66 * MiB, WS_Y = 130 * MiB, WS_Z = 162 * MiB, WS_END = 482 * MiB;
constexpr int LDS_RING = 131072, LDS_MISC = LDS_RING, LDS_BYTES = LDS_RING + 1024;
constexpr int NPHASE = 18;

typedef const f32x4 (&AccRef)[2][2][4][2];
__device__ __forceinline__ void epi_z(AccRef acc, const pg8::Unit& u, int wr, int wc, int fr, int fq, bf16_t* Z) {
    const int pn = u.pn; const int row0 = u.pm * 256 + wr * 64 + fr;
    if (pn >= 12) {
        const int col0 = (pn - 12) * 256 + wc * 32 + 8 * fq;
#pragma unroll
        for (int ai = 0; ai < 2; ++ai)
#pragma unroll
            for (int m = 0; m < 4; ++m) { bf16_t* rowp = Z + ZO_G + (size_t)(row0 + ai * 128 + m * 16) * GP + col0;
#pragma unroll
                for (int bj = 0; bj < 2; ++bj) { f32x4 v0 = acc[ai][bj][m][0], v1 = acc[ai][bj][m][1];
#pragma unroll
                    for (int e = 0; e < 4; ++e) { v0[e] = sigmoidf_fast(v0[e]); v1[e] = sigmoidf_fast(v1[e]); }
                    u32x4 w; w.x = cvtpk(v0[0], v0[1]); w.y = cvtpk(v0[2], v0[3]); w.z = cvtpk(v1[0], v1[1]); w.w = cvtpk(v1[2], v1[3]);
                    *(u32x4*)(rowp + bj * 128) = w; } }
        return;
    }
    const bool isA = pn < 9; const int sec = isA ? pn / 3 : pn - 9, g = isA ? pn % 3 : 0, sh = 2 * g;
    const float sc = (sec == 0) ? C2 : 1.0f;
    bf16_t* base = Z + (isA ? ZO_QA + (size_t)sec * HM_A : ZO_QB + (size_t)sec * HM_B);
    const int b = u.pm >> 4, nh = isA ? 12 : 4;
    const int dc = ((wc & 1) * 32 + 8 * fq);
#pragma unroll
    for (int ai = 0; ai < 2; ++ai)
#pragma unroll
        for (int m = 0; m < 4; ++m) { const int srow = (row0 + ai * 128 + m * 16) & (SEQ - 1);
            const int pos = ((srow & ((1 << sh) - 1)) << (12 - sh)) + (srow >> sh);
#pragma unroll
            for (int bj = 0; bj < 2; ++bj) { const int head = g * 4 + bj * 2 + (wc >> 1);
                f32x4 v0 = acc[ai][bj][m][0] * sc, v1 = acc[ai][bj][m][1] * sc;
                u32x4 w; w.x = cvtpk(v0[0], v0[1]); w.y = cvtpk(v0[2], v0[3]); w.z = cvtpk(v1[0], v1[1]); w.w = cvtpk(v1[2], v1[3]);
                *(u32x4*)(base + ((size_t)(b * nh + head) * SEQ + pos) * 64 + dc) = w; } }
}
__device__ __forceinline__ void epi_up(AccRef acc, const pg8::Unit& u, int wr, int wc, int fr, int fq, const bf16_t* G, bf16_t* O) {
    const int row0 = u.pm * 256 + wr * 64 + fr, col0 = u.pn * 128 + wc * 32 + 8 * fq;
#pragma unroll
    for (int ai = 0; ai < 2; ++ai) {
        u32x4 ga[4], gb[4];
#pragma unroll
        for (int m = 0; m < 4; ++m) { const size_t row = (size_t)(row0 + ai * 128 + m * 16); ga[m] = *(const u32x4*)(G + row * GP + col0); gb[m] = *(const u32x4*)(G + row * GP + 1024 + col0); }
#pragma unroll
        for (int m = 0; m < 4; ++m) { const size_t row = (size_t)(row0 + ai * 128 + m * 16);
            const f32x4 a0 = acc[ai][0][m][0], a1 = acc[ai][0][m][1], b0 = acc[ai][1][m][0], b1 = acc[ai][1][m][1]; f32x4 v0, v1;
            v0[0] = a0[0] * bf_lo(ga[m].x) + b0[0] * bf_lo(gb[m].x); v0[1] = a0[1] * bf_hi(ga[m].x) + b0[1] * bf_hi(gb[m].x); v0[2] = a0[2] * bf_lo(ga[m].y) + b0[2] * bf_lo(gb[m].y); v0[3] = a0[3] * bf_hi(ga[m].y) + b0[3] * bf_hi(gb[m].y);
            v1[0] = a1[0] * bf_lo(ga[m].z) + b1[0] * bf_lo(gb[m].z); v1[1] = a1[1] * bf_hi(ga[m].z) + b1[1] * bf_hi(gb[m].z); v1[2] = a1[2] * bf_lo(ga[m].w) + b1[2] * bf_lo(gb[m].w); v1[3] = a1[3] * bf_hi(ga[m].w) + b1[3] * bf_hi(gb[m].w);
            u32x4 w; w.x = cvtpk(v0[0], v0[1]); w.y = cvtpk(v0[2], v0[3]); w.z = cvtpk(v1[0], v1[1]); w.w = cvtpk(v1[2], v1[3]);
            *(u32x4*)(O + row * DM + col0) = w; }
        asm volatile("" ::: "memory"); }
}
__device__ __forceinline__ void epi_res(AccRef acc, const pg8::Unit& u, int wr, int wc, int fr, int fq, const float* xin, float* xout, const float* g) {
    const float* gb = g + (size_t)(u.pm >> 4) * NMODC; const int col0 = u.pn * 256 + wc * 32 + 8 * fq;
    f32x4 gv[2][2];
#pragma unroll
    for (int bj = 0; bj < 2; ++bj)
#pragma unroll
        for (int n = 0; n < 2; ++n) gv[bj][n] = *(const f32x4*)(gb + col0 + bj * 128 + n * 4);
#pragma unroll
    for (int ai = 0; ai < 2; ++ai) {
        f32x4 xv[4][2][2];
#pragma unroll
        for (int m = 0; m < 4; ++m) { const size_t off = (size_t)(u.pm * 256 + ai * 128 + wr * 64 + m * 16 + fr) * DM + col0;
#pragma unroll
            for (int bj = 0; bj < 2; ++bj)
#pragma unroll
                for (int n = 0; n < 2; ++n) xv[m][bj][n] = *(const f32x4*)(xin + off + bj * 128 + n * 4); }
#pragma unroll
        for (int m = 0; m < 4; ++m) { const size_t off = (size_t)(u.pm * 256 + ai * 128 + wr * 64 + m * 16 + fr) * DM + col0;
#pragma unroll
            for (int bj = 0; bj < 2; ++bj)
#pragma unroll
                for (int n = 0; n < 2; ++n) *(f32x4*)(xout + off + bj * 128 + n * 4) = xv[m][bj][n] + gv[bj][n] * acc[ai][bj][m][n]; }
        asm volatile("" ::: "memory"); }
}
__device__ __forceinline__ void epi_swi(AccRef acc, const pg8::Unit& u, int wr, int wc, int fr, int fq, bf16_t* O) {
    const int row0 = u.pm * 256 + wr * 64 + fr, col0 = u.pn * 128 + wc * 32 + 8 * fq;
#pragma unroll
    for (int ai = 0; ai < 2; ++ai)
#pragma unroll
        for (int m = 0; m < 4; ++m) { f32x4 h0, h1;
#pragma unroll
            for (int e = 0; e < 4; ++e) { const float g0 = acc[ai][0][m][0][e], g1 = acc[ai][0][m][1][e];
                h0[e] = g0 * sigmoidf_fast(g0) * acc[ai][1][m][0][e]; h1[e] = g1 * sigmoidf_fast(g1) * acc[ai][1][m][1][e]; }
            u32x4 w; w.x = cvtpk(h0[0], h0[1]); w.y = cvtpk(h0[2], h0[3]); w.z = cvtpk(h1[0], h1[1]); w.w = cvtpk(h1[2], h1[3]);
            *(u32x4*)(O + (size_t)(row0 + ai * 128 + m * 16) * DFF + col0) = w; }
}
struct EpiUpOnly {
    static constexpr bool PERM = true;
    const bf16_t* G; bf16_t* O;
    __device__ __forceinline__ void operator()(AccRef acc, const pg8::Unit& u, int wr, int wc, int fr, int fq) const { epi_up(acc, u, wr, wc, fr, fq, G, O); }
};
struct EpiAny {
    static constexpr bool PERM = true;
    int mode; const void* src; void* dst; const float* g;
    __device__ __forceinline__ void operator()(AccRef acc, const pg8::Unit& u, int wr, int wc, int fr, int fq) const {
        switch (mode) {
        case 0: epi_z(acc, u, wr, wc, fr, fq, (bf16_t*)dst); break;
        case 3: epi_res(acc, u, wr, wc, fr, fq, (const float*)src, (float*)dst, g); break;
        default: epi_swi(acc, u, wr, wc, fr, fq, (bf16_t*)dst); break;
        }
    }
};

__device__ __forceinline__ float lane_xor(float v, int o, int lane) { return __int_as_float(__builtin_amdgcn_ds_bpermute((lane ^ o) << 2, __float_as_int(v))); }
__device__ __forceinline__ float wave_sum(float v, int lane) {
#pragma unroll
    for (int o = 1; o < 64; o <<= 1) v += lane_xor(v, o, lane);
    return v;
}
__device__ __forceinline__ int crow(int r, int hi) { return (r & 3) + 8 * (r >> 2) + 4 * hi; }

__device__ __forceinline__ void zero_item(bf16_t* WT, int K, int dstrow, int k0, int lane) {
    const int c = lane & 7;
#pragma unroll
    for (int j = 0; j < 4; ++j) { const int n = (lane >> 3) + 8 * j; *(u32x4*)(WT + (size_t)(dstrow + n) * K + k0 + 8 * c) = (u32x4){0u, 0u, 0u, 0u}; }
}
__device__ __forceinline__ void transpose_item(const float* W, int ldw, int srccol, bf16_t* WT, int K, int dstrow, int k0, LAS float* scr, int lane, int srck0 = -1) {
    if (srck0 < 0) srck0 = k0;
    float tv[32];
#pragma unroll
    for (int i = 0; i < 32; ++i) tv[i] = W[(size_t)(srck0 + 2 * i + (lane >> 5)) * ldw + srccol + (lane & 31)];
#pragma unroll
    for (int i = 0; i < 32; ++i) scr[(2 * i + (lane >> 5)) * 33 + (lane & 31)] = tv[i];
    asm volatile("s_waitcnt lgkmcnt(0)" ::: "memory");
    const int c = lane & 7;
#pragma unroll
    for (int j = 0; j < 4; ++j) { const int n = (lane >> 3) + 8 * j; const LAS float* s = scr + (8 * c) * 33 + n;
        u32x4 o; o.x = cvtpk(s[0 * 33], s[1 * 33]); o.y = cvtpk(s[2 * 33], s[3 * 33]); o.z = cvtpk(s[4 * 33], s[5 * 33]); o.w = cvtpk(s[6 * 33], s[7 * 33]);
        *(u32x4*)(WT + (size_t)(dstrow + n) * K + k0 + 8 * c) = o; }
    asm volatile("s_waitcnt lgkmcnt(0)" ::: "memory");
}

struct Args { const float* in[14]; float* out; unsigned char* ws; int ph_lo, ph_hi; };
typedef const __attribute__((address_space(4))) Args* KArgs;

__device__ __forceinline__ void phase_prologue(KArgs a, LAS unsigned char* lds, int tid, int lane, int wid) {
    const float* c = a->in[1]; const float* w_ada = a->in[2]; const float* b_ada = a->in[3];
    float* mod = (float*)(a->ws + WS_MOD);
    for (int cgp = blockIdx.x; cgp < 48; cgp += gridDim.x) {
        LAS float* cact = (LAS float*)lds;
        LAS float* red = (LAS float*)(lds + 32768);
        for (int i = tid; i < 8192; i += 512) { const int b = i >> 10, k = i & 1023; const float v = c[i]; cact[k * 8 + b] = v * sigmoidf_fast(v); }
        __syncthreads();
        const int l = cgp / 24, col0 = (cgp % 24) * 256;
        float acc[8][4];
#pragma unroll
        for (int b = 0; b < 8; ++b)
#pragma unroll
            for (int e = 0; e < 4; ++e) acc[b][e] = 0.f;
        const float* wp = w_ada + ((size_t)l * DM + wid * 128) * NMODC + col0 + 4 * lane;
#pragma unroll 32
        for (int k = 0; k < 128; ++k) {
            const f32x4 wv = *(const f32x4*)(wp + (size_t)k * NMODC);
            const f32x4 c0 = *(const LAS f32x4*)(cact + (wid * 128 + k) * 8), c1 = *(const LAS f32x4*)(cact + (wid * 128 + k) * 8 + 4);
#pragma unroll
            for (int e = 0; e < 4; ++e) { acc[0][e] += c0[0] * wv[e]; acc[1][e] += c0[1] * wv[e]; acc[2][e] += c0[2] * wv[e]; acc[3][e] += c0[3] * wv[e];
                                          acc[4][e] += c1[0] * wv[e]; acc[5][e] += c1[1] * wv[e]; acc[6][e] += c1[2] * wv[e]; acc[7][e] += c1[3] * wv[e]; }
        }
#pragma unroll
        for (int b = 0; b < 8; ++b)
#pragma unroll
            for (int e = 0; e < 4; ++e) red[(wid * 32 + b * 4 + e) * 64 + lane] = acc[b][e];
        __syncthreads();
#pragma unroll
        for (int i = 0; i < 4; ++i) { const int o = tid + 512 * i, b = o >> 8, cl = o & 255, ln = cl >> 2, e = cl & 3;
            float s = b_ada[(size_t)l * NMODC + col0 + cl];
#pragma unroll
            for (int w = 0; w < 8; ++w) s += red[(w * 32 + b * 4 + e) * 64 + ln];
            mod[((size_t)l * 8 + b) * NMODC + col0 + cl] = s; }
        __syncthreads();
    }
    LAS float* scr = (LAS float*)(lds + wid * 8448);
    const int gw = blockIdx.x * 8 + wid, NGW = gridDim.x * 8;
    constexpr int I_IN = 160 * 16, I_UP = 64 * 8, I_OUT = 32 * 16, I_FFI = 176 * 16, I_FFO = 32 * 44, I_LAYER = I_IN + I_UP + I_OUT + I_FFI + I_FFO;
    constexpr int IT_ALL = 2 * I_LAYER, IT_MAIN = 13312;
    static_assert(IT_ALL > IT_MAIN && IT_ALL - IT_MAIN <= 384 * 8, "prologue item split");
    const bool split = (gridDim.x == 256);
    const int it0 = !split ? gw : (blockIdx.x < 48 ? IT_MAIN + gw : gw - 384), itstep = !split ? NGW : (blockIdx.x < 48 ? 384 : 1664), itend = (!split || blockIdx.x < 48) ? IT_ALL : IT_MAIN;
    for (int it = it0; it < itend; it += itstep) {
        const int l = it / I_LAYER; int r = it % I_LAYER;
        unsigned char* wl = a->ws + WS_W + (size_t)l * W_LAYER;
        if (r < I_IN) { const int nb = r % 160, kb = r / 160, dr = nb * 32; transpose_item(a->in[5] + (size_t)l * DM * DIN, DIN, dr < 3072 ? dr : dr + 4, (bf16_t*)(wl + WO_IN), DM, dr, kb * 64, scr, lane); continue; } r -= I_IN;
        if (r < I_UP) {
            const int nb = r % 64, kb = r / 64, dr = nb * 32, pn = dr >> 8, w = dr & 255, br = w >> 7, ch = pn * 128 + (w & 127);
            if ((kb & 1) == br) transpose_item(a->in[br ? 8 : 7] + (size_t)l * 256 * DM, DM, ch, (bf16_t*)(wl + WO_UP), 512, dr, kb * 64, scr, lane, (kb >> 1) * 64);
            else zero_item((bf16_t*)(wl + WO_UP), 512, dr, kb * 64, lane);
            continue; } r -= I_UP;
        if (r < I_OUT) { const int nb = r % 32, kb = r / 32; transpose_item(a->in[9] + (size_t)l * DM * DM, DM, nb * 32, (bf16_t*)(wl + WO_OUT), DM, nb * 32, kb * 64, scr, lane); continue; } r -= I_OUT;
        if (r < I_FFI) { const int nb = r % 176, kb = r / 176, dr = nb * 32, pn = dr >> 8, wi = dr & 255; const int sc = wi < 128 ? pn * 128 + wi : DFF + pn * 128 + (wi - 128);
            transpose_item(a->in[11] + (size_t)l * DM * 2 * DFF, 2 * DFF, sc, (bf16_t*)(wl + WO_FFI), DM, dr, kb * 64, scr, lane); continue; } r -= I_FFI;
        { const int nb = r % 32, kb = r / 32; transpose_item(a->in[12] + (size_t)l * DFF * DM, DM, nb * 32, (bf16_t*)(wl + WO_FFO), DFF, nb * 32, kb * 64, scr, lane); }
    }
}

template <int SUB>
__device__ __forceinline__ void phase_norm(KArgs a, int l, LAS unsigned char* lds, int tid, int lane, int wid) {
    const float* xin = (SUB == 1 && l == 0) ? a->in[0] : a->out;
    const float* mod = (const float*)(a->ws + WS_MOD);
    bf16_t* H = (bf16_t*)(a->ws + WS_H);
    float* logf_out = (float*)(a->ws + WS_LOGF);
    LAS f32x4* Al = (LAS f32x4*)lds; LAS f32x4* Bl = (LAS f32x4*)(lds + 4096);
    for (int rb = blockIdx.x; rb < T_TOK / 128; rb += gridDim.x) {
        const int b = rb >> 5;
        const size_t rbase = (size_t)rb * 128 + wid * 16;
        constexpr int NPRE = (SUB == 1) ? 3 : 2;
        f32x4 vn[NPRE][4];
#pragma unroll
        for (int p = 0; p < NPRE; ++p)
#pragma unroll
            for (int j = 0; j < 4; ++j) vn[p][j] = *((const f32x4*)(xin + (rbase + p) * DM) + lane + 64 * j);
        __syncthreads();
        for (int i = tid; i < DM; i += 512) {
            float av, bv;
            if (SUB == 3) { av = a->in[13][i]; bv = 0.f; }
            else { const float* mb = mod + ((size_t)l * 8 + b) * NMODC; const float nw = (SUB == 1 ? a->in[4] : a->in[10])[l * DM + i];
                   av = nw * (1.0f + mb[(SUB == 1 ? 1 : 4) * DM + i]); bv = mb[(SUB == 1 ? 0 : 3) * DM + i]; }
            ((LAS float*)Al)[i] = av; ((LAS float*)Bl)[i] = bv;
        }
        __syncthreads();
        f32x4 wf[16]; float bfv[4] = {0.f, 0.f, 0.f, 0.f};
        if (SUB == 1) {
            const float* wfp = a->in[5] + (size_t)l * DM * DIN + 3072;
#pragma unroll
            for (int j = 0; j < 4; ++j)
#pragma unroll
                for (int e = 0; e < 4; ++e) wf[j * 4 + e] = *(const f32x4*)(wfp + (size_t)(4 * lane + 256 * j + e) * DIN);
#pragma unroll
            for (int n = 0; n < 4; ++n) bfv[n] = a->in[6][l * 4 + n];
        }
        auto do_row = [&](const f32x4 (&v)[4], const size_t row) __attribute__((always_inline)) {
            float ss = 0.f;
#pragma unroll
            for (int j = 0; j < 4; ++j) ss += (v[j].x * v[j].x + v[j].y * v[j].y) + (v[j].z * v[j].z + v[j].w * v[j].w);
            const float rstd = 1.0f / sqrtf(wave_sum(ss, lane) * (1.0f / DM) + 1e-6f);
            float fz[4] = {0.f, 0.f, 0.f, 0.f};
#pragma unroll
            for (int j = 0; j < 4; ++j) {
                const f32x4 hv = v[j] * rstd * Al[lane + 64 * j] + Bl[lane + 64 * j];
                if (SUB == 3) { *((f32x4*)(a->out + row * DM) + lane + 64 * j) = hv; }
                else { u32x2 w; w.x = cvtpk(hv[0], hv[1]); w.y = cvtpk(hv[2], hv[3]); *(u32x2*)(H + row * DM + 4 * lane + 256 * j) = w; }
                if (SUB == 1) {
#pragma unroll
                    for (int e = 0; e < 4; ++e)
#pragma unroll
                        for (int n = 0; n < 4; ++n) fz[n] += hv[e] * wf[j * 4 + e][n];
                }
            }
            if (SUB == 1) {
                f32x4 lf;
#pragma unroll
                for (int n = 0; n < 4; ++n) { const float y = wave_sum(fz[n], lane) + bfv[n];
                    const float e_ = __builtin_amdgcn_exp2f(-LOG2E * fabsf(y));
                    lf[n] = fminf(y, 0.f) - (e_ < 1e-3f ? e_ * (1.0f - 0.5f * e_) : 0.69314718056f * __builtin_amdgcn_logf(1.0f + e_)); }
                if (lane == 0) *(f32x4*)(logf_out + row * 4) = lf;
            }
        };
        if constexpr (SUB == 1) {
            constexpr int PD = 3;
#pragma unroll
            for (int i = 0; i < 16; ++i) {
                f32x4 v[4];
#pragma unroll
                for (int j = 0; j < 4; ++j) v[j] = vn[i % PD][j];
                if (i + PD < 16) {
#pragma unroll
                    for (int j = 0; j < 4; ++j) vn[i % PD][j] = *((const f32x4*)(xin + (rbase + i + PD) * DM) + lane + 64 * j); }
                do_row(v, rbase + i);
            }
        } else {
            for (int i = 0; i < 16; i += 2) {
                f32x4 v[2][4];
#pragma unroll
                for (int q = 0; q < 2; ++q)
#pragma unroll
                    for (int j = 0; j < 4; ++j) v[q][j] = vn[q][j];
                if (i + 2 < 16) {
#pragma unroll
                    for (int q = 0; q < 2; ++q)
#pragma unroll
                        for (int j = 0; j < 4; ++j) vn[q][j] = *((const f32x4*)(xin + (rbase + i + 2 + q) * DM) + lane + 64 * j); }
                do_row(v[0], rbase + i); do_row(v[1], rbase + i + 1);
            }
        }
    }
}

__device__ __forceinline__ void phase_scan(KArgs a, LAS unsigned char* lds, int tid, int lane, int wid) {
    const float* logf_in = (const float*)(a->ws + WS_LOGF); float* F2 = (float*)(a->ws + WS_F2);
    LAS float* wt = (LAS float*)(lds + LDS_MISC);
    for (int bh = blockIdx.x; bh < 32; bh += gridDim.x) {
        const int b = bh >> 2, h = bh & 3;
        float v[8]; float run = 0.f;
#pragma unroll
        for (int i = 0; i < 8; ++i) { run += logf_in[((size_t)b * SEQ + 8 * tid + i) * 4 + h]; v[i] = run; }
        float incl = run;
#pragma unroll
        for (int o = 1; o < 64; o <<= 1) { const float t = __int_as_float(__builtin_amdgcn_ds_bpermute(((lane - o) & 63) << 2, __float_as_int(incl))); if (lane >= o) incl += t; }
        __syncthreads();
        if (lane == 63) wt[wid] = incl;
        __syncthreads();
        float off = incl - run;
        for (int w = 0; w < wid; ++w) off += wt[w];
#pragma unroll
        for (int i = 0; i < 8; ++i) F2[(size_t)bh * SEQ + 8 * tid + i] = (v[i] + off) * LOG2E;
    }
    __syncthreads();
}

typedef short v4i16_t __attribute__((ext_vector_type(4)));
__device__ __forceinline__ s16x4 vtr(const LAS unsigned char* p) { return __builtin_bit_cast(s16x4, __builtin_amdgcn_ds_read_tr16_b64_v4i16((LAS v4i16_t*)p)); }
__device__ __forceinline__ float hmax2(float m) { auto rr = __builtin_amdgcn_permlane32_swap(__float_as_uint(m), __float_as_uint(m), false, false); return fmaxf(__uint_as_float(rr[0]), __uint_as_float(rr[1])); }
__device__ __forceinline__ float hsum2(float m) { auto rr = __builtin_amdgcn_permlane32_swap(__float_as_uint(m), __float_as_uint(m), false, false); return __uint_as_float(rr[0]) + __uint_as_float(rr[1]); }

#define ATT_THR 3.0f
template <int NS>
__device__ __forceinline__ void attn_qk(const bf16x8 (&kf)[NS][4], const bf16x8 (&qr)[4], f32x16 (&s)[NS]) {
#pragma unroll
    for (int d0 = 0; d0 < 4; ++d0)
#pragma unroll
        for (int i = 0; i < NS; ++i) s[i] = __builtin_amdgcn_mfma_f32_32x32x16_bf16(kf[i][d0], qr[d0], s[i], 0, 0, 0);
}
template <int NS>
__device__ __forceinline__ void attn_sm(f32x16 (&s)[NS], const LAS unsigned char* vb, int vhalf, bool first, float& m, float& l, f32x16& o0, f32x16& o1) {
    float rm = fmaxf(s[0][0], s[0][1]), rm2 = fmaxf(s[0][2], s[0][3]);
#pragma unroll
    for (int i = 0; i < NS; ++i)
#pragma unroll
        for (int r = (i == 0 ? 4 : 0); r < 16; r += 4) { rm = __builtin_fmaxf(__builtin_fmaxf(rm, s[i][r]), s[i][r + 1]); rm2 = __builtin_fmaxf(__builtin_fmaxf(rm2, s[i][r + 2]), s[i][r + 3]); }
    rm = fmaxf(rm, rm2);
    rm = hmax2(rm);
    if (first || __any(rm > ATT_THR)) {
        const float delta = first ? rm : fmaxf(rm, 0.f);
        m += delta;
        const float f = __builtin_amdgcn_exp2f(-delta);
        l *= f; o0 = o0 * f; o1 = o1 * f;
#pragma unroll
        for (int i = 0; i < NS; ++i) s[i] = s[i] - delta;
    }
    float ps = 0.f;
#pragma unroll
    for (int i = 0; i < NS; ++i)
#pragma unroll
        for (int r = 0; r < 16; ++r) { s[i][r] = __builtin_amdgcn_exp2f(s[i][r]); ps += s[i][r]; }
    l += ps;
#pragma unroll
    for (int i = 0; i < NS; ++i) {
        u32x4 p0 = {cvtpk(s[i][0], s[i][1]), cvtpk(s[i][2], s[i][3]), cvtpk(s[i][4], s[i][5]), cvtpk(s[i][6], s[i][7])};
        u32x4 p1 = {cvtpk(s[i][8], s[i][9]), cvtpk(s[i][10], s[i][11]), cvtpk(s[i][12], s[i][13]), cvtpk(s[i][14], s[i][15])};
        const bf16x8 pb0 = __builtin_bit_cast(bf16x8, p0), pb1 = __builtin_bit_cast(bf16x8, p1);
#pragma unroll
        for (int st = 0; st < 2; ++st) {
            const LAS unsigned char* vp = vb + i * 2048 + st * 1024;
            const s16x4 a0 = vtr(vp), a1 = vtr(vp + 512), b0 = vtr(vp + vhalf), b1 = vtr(vp + vhalf + 512);
            const bf16x8 vf0 = {a0[0], a0[1], a0[2], a0[3], a1[0], a1[1], a1[2], a1[3]}, vf1 = {b0[0], b0[1], b0[2], b0[3], b1[0], b1[1], b1[2], b1[3]};
            o0 = __builtin_amdgcn_mfma_f32_32x32x16_bf16(vf0, st ? pb1 : pb0, o0, 0, 0, 0);
            o1 = __builtin_amdgcn_mfma_f32_32x32x16_bf16(vf1, st ? pb1 : pb0, o1, 0, 0, 0);
        }
    }
}

__device__ __forceinline__ void fox_unit(KArgs a, LAS unsigned char* lds, int b, int h, int qb, int tid, int lane, int wid) {
    const bf16_t* Z = (const bf16_t*)(a->ws + WS_Z); const float* F2 = (const float*)(a->ws + WS_F2) + (size_t)(b * 4 + h) * SEQ; bf16_t* YB = (bf16_t*)(a->ws + WS_Y) + 64;
    const int r32 = lane & 31, hi = lane >> 5;
    constexpr int FB = 17664;
    const int qrow = qb * 256 + wid * 32 + r32; const size_t tok = (size_t)b * SEQ + qrow;
    bf16x8 qr[4];
#pragma unroll
    for (int d0 = 0; d0 < 4; ++d0) qr[d0] = *(const bf16x8*)(Z + ZO_QB + ((size_t)(b * 4 + h) * SEQ + qrow) * 64 + d0 * 16 + hi * 8);
    const float Fq = F2[qrow];
    const int wfirst = qb * 256 + wid * 32, wlast = wfirst + 31;
    const int NT = (qb + 1) * 4;
    const int lkey = tid >> 3, lch = tid & 7;
    const bf16_t* ksrc = Z + ZO_KB + ((size_t)(b * 4 + h) * SEQ + lkey) * 64 + lch * 8;
    const bf16_t* vsrc = Z + ZO_VB + ((size_t)(b * 4 + h) * SEQ + lkey) * 64 + lch * 8;
    u32x4 kr0 = *(const u32x4*)(ksrc + (size_t)(NT - 1) * 64 * 64), vr0 = *(const u32x4*)(vsrc + (size_t)(NT - 1) * 64 * 64); float fr0 = (tid < 64) ? F2[(NT - 1) * 64 + tid] : 0.f;
    u32x4 kr1 = *(const u32x4*)(ksrc + (size_t)(NT - 2) * 64 * 64), vr1 = *(const u32x4*)(vsrc + (size_t)(NT - 2) * 64 * 64); float fr1 = (tid < 64) ? F2[(NT - 2) * 64 + tid] : 0.f;
    float m = 0.f, l = 0.f, fqm = Fq; f32x16 o0 = {}, o1 = {}; bool first = true;
    const int vlane = (4 * hi + ((lane & 15) >> 2)) * 64 + ((lane >> 4) & 1) * 32 + (lane & 3) * 8;
    __syncthreads();
    *(LAS u32x4*)(lds + lkey * 144 + lch * 16) = kr0;
    *(LAS u32x4*)(lds + 9216 + (lch >> 2) * 4096 + lkey * 64 + (lch & 3) * 16) = vr0;
    if (tid < 64) *(LAS float*)(lds + 17408 + tid * 4) = fr0;
    __syncthreads();
#define FOX_STEP(it_, KN, VN, FN, KW, VW, FW) do { const int it = (it_); const int t = NT - 1 - it; LAS unsigned char* buf = lds + (it & 1) * FB; LAS unsigned char* nbuf = lds + ((it & 1) ^ 1) * FB; \
        if (it + 2 < NT) { KN = *(const u32x4*)(ksrc + (size_t)(t - 2) * 64 * 64); VN = *(const u32x4*)(vsrc + (size_t)(t - 2) * 64 * 64); if (tid < 64) FN = F2[(t - 2) * 64 + tid]; } \
        if (t * 64 <= wlast) { \
            bf16x8 kf[2][4]; f32x16 s[2]; \
            _Pragma("unroll") for (int kk = 0; kk < 2; ++kk) _Pragma("unroll") for (int d0 = 0; d0 < 4; ++d0) kf[kk][d0] = *(const LAS bf16x8*)(buf + (kk * 32 + r32) * 144 + d0 * 32 + hi * 16); \
            const LAS float* Ft = (const LAS float*)(buf + 17408); \
            _Pragma("unroll") for (int kk = 0; kk < 2; ++kk) _Pragma("unroll") for (int g = 0; g < 4; ++g) { const f32x4 fk = *(const LAS f32x4*)(Ft + kk * 32 + 8 * g + 4 * hi); \
                _Pragma("unroll") for (int e = 0; e < 4; ++e) s[kk][4 * g + e] = fqm - fk[e]; } \
            if (t * 64 + 63 > wfirst) { \
                _Pragma("unroll") for (int kk = 0; kk < 2; ++kk) _Pragma("unroll") for (int r = 0; r < 16; ++r) if (t * 64 + kk * 32 + crow(r, hi) > qrow) s[kk][r] = -INFINITY; } \
            attn_qk<2>(kf, qr, s); attn_sm<2>(s, buf + 9216 + vlane, 4096, first, m, l, o0, o1); \
            first = false; fqm = Fq - m; } \
        if (it + 1 < NT) { \
            *(LAS u32x4*)(nbuf + lkey * 144 + lch * 16) = KW; \
            *(LAS u32x4*)(nbuf + 9216 + (lch >> 2) * 4096 + lkey * 64 + (lch & 3) * 16) = VW; \
            if (tid < 64) *(LAS float*)(nbuf + 17408 + tid * 4) = FW; } \
        __syncthreads(); } while (0)
#pragma unroll 1
    for (int it2 = 0; it2 < NT; it2 += 2) {
        FOX_STEP(it2, kr0, vr0, fr0, kr1, vr1, fr1);
        FOX_STEP(it2 + 1, kr1, vr1, fr1, kr0, vr0, fr0);
    }
#undef FOX_STEP
    const float rl = 1.0f / hsum2(l);
    bf16_t* op = YB + tok * 512 + h * 128;
#pragma unroll
    for (int g = 0; g < 4; ++g) {
        u32x2 w0 = {cvtpk(o0[4 * g] * rl, o0[4 * g + 1] * rl), cvtpk(o0[4 * g + 2] * rl, o0[4 * g + 3] * rl)};
        u32x2 w1 = {cvtpk(o1[4 * g] * rl, o1[4 * g + 1] * rl), cvtpk(o1[4 * g + 2] * rl, o1[4 * g + 3] * rl)};
        *(u32x2*)(op + 8 * g + 4 * hi) = w0; *(u32x2*)(op + 32 + 8 * g + 4 * hi) = w1;
    }
}

__device__ __forceinline__ void dil_item(KArgs a, LAS unsigned char* lds, int item, int tid, int lane, int wid) {
    const bf16_t* Z = (const bf16_t*)(a->ws + WS_Z); bf16_t* YA = (bf16_t*)(a->ws + WS_Y);
    unsigned char* tmpb = a->ws + WS_H + (size_t)blockIdx.x * (3 * 512 * 64 * 2 + 3 * 512 * 4);
    bf16_t* TO = (bf16_t*)tmpb; float* TL = (float*)(tmpb + 3 * 512 * 64 * 2);
    const int b = item >> 5, slot = (item >> 3) & 3, s0 = (item & 7) * 512;
    const int r32 = lane & 31, hi = lane >> 5;
    LAS unsigned char* vbuf = lds + wid * 4096;
    const LAS unsigned char* vb0 = vbuf + (4 * hi + ((lane & 15) >> 2)) * 64 + ((lane >> 4) & 1) * 32 + (lane & 3) * 8;
    __syncthreads();
#pragma unroll 1
    for (int g = 0; g < 3; ++g) {
        const int sh = 2 * g, d = 1 << sh, head = 4 * g + slot;
        const float slope2 = exp2f(-8.0f * (float)(head + 1) / 12.0f) * (float)d * LOG2E;
#pragma unroll 1
        for (int j = 0; j < 2; ++j) {
            const int sub = wid * 2 + j, spc = 16 >> sh, cls = sub / spc, lsub = sub % spc;
            const int l0 = (s0 >> sh) + lsub * 32;
            const size_t hb = ((size_t)(b * 12 + head) * SEQ + (size_t)cls * (SEQ >> sh)) * 64;
            const int tl = (l0 + r32) * d + cls - s0;
            bf16x8 qr[4];
            { const bf16_t* qp = Z + ZO_QA + hb + (size_t)(l0 + r32) * 64 + hi * 8;
#pragma unroll
              for (int d0 = 0; d0 < 4; ++d0) qr[d0] = *(const bf16x8*)(qp + d0 * 16); }
            float m = 0.f, l = 0.f; f32x16 o0 = {}, o1 = {};
            const int cstart = (l0 >= 128) ? 0 : ((128 - l0) >> 5);
            bf16x8 kA[1][4], kB[1][4]; u32x4 vA[4], vB[4];
            const bf16_t* kbase = Z + ZO_KA + hb + (size_t)(l0 - 128 + r32) * 64 + hi * 8;
            const bf16_t* vbase = Z + ZO_VA + hb + (size_t)(l0 - 128 + (lane >> 3)) * 64 + (lane & 7) * 8;
            const float sl4 = slope2 * (float)(4 * hi);
#define DIL_LOADK(KF, c) do { if ((c) >= cstart) { _Pragma("unroll") for (int d0 = 0; d0 < 4; ++d0) KF[0][d0] = *(const bf16x8*)(kbase + (c) * 2048 + d0 * 16); } } while (0)
#define DIL_LOADV(VR, c) do { if ((c) >= cstart) { _Pragma("unroll") for (int i = 0; i < 4; ++i) VR[i] = *(const u32x4*)(vbase + (c) * 2048 + i * 512); } } while (0)
#define DIL_STEP(KF, VR, c) do { if ((c) >= cstart) { \
                _Pragma("unroll") for (int i = 0; i < 4; ++i) { const int idx = i * 64 + lane, kv = idx >> 3, ch = idx & 7; *(LAS u32x4*)(vbuf + (ch >> 2) * 2048 + kv * 64 + (ch & 3) * 16) = VR[i]; } \
                if ((c) >= 2) DIL_LOADV(VR, (c) - 2); \
                f32x16 s[1]; const float t1 = sl4 - slope2 * (float)(128 + r32 - 32 * (c)) - m;        \
                _Pragma("unroll") for (int r = 0; r < 16; ++r) { const int kc_ = (r & 3) + 8 * (r >> 2); float v_ = slope2 * (float)kc_ + t1; \
                    if ((c) == 4) { if (kc_ + 4 * hi > r32) v_ = -INFINITY; } \
                    if ((c) == 0) { if (kc_ + 4 * hi < r32) v_ = -INFINITY; } \
                    s[0][r] = v_; } \
                attn_qk<1>(KF, qr, s); \
                if ((c) >= 2) DIL_LOADK(KF, (c) - 2); \
                attn_sm<1>(s, vb0, 2048, (c) == 4, m, l, o0, o1); } } while (0)
            DIL_LOADK(kA, 4); DIL_LOADV(vA, 4); DIL_LOADK(kB, 3); DIL_LOADV(vB, 3);
            DIL_STEP(kA, vA, 4);
            DIL_STEP(kB, vB, 3);
            DIL_STEP(kA, vA, 2);
            DIL_STEP(kB, vB, 1);
            DIL_STEP(kA, vA, 0);
#undef DIL_STEP
#undef DIL_LOADK
#define DIL_LOAD DIL_LOADV
#undef DIL_LOAD
            l = hsum2(l);
            const float rl = 1.0f / l;
            bf16_t* op = TO + ((size_t)g * 512 + tl) * 64;
#pragma unroll
            for (int gg = 0; gg < 4; ++gg) {
                u32x2 w0 = {cvtpk(o0[4 * gg] * rl, o0[4 * gg + 1] * rl), cvtpk(o0[4 * gg + 2] * rl, o0[4 * gg + 3] * rl)};
                u32x2 w1 = {cvtpk(o1[4 * gg] * rl, o1[4 * gg + 1] * rl), cvtpk(o1[4 * gg + 2] * rl, o1[4 * gg + 3] * rl)};
                *(u32x2*)(op + 8 * gg + 4 * hi) = w0; *(u32x2*)(op + 32 + 8 * gg + 4 * hi) = w1;
            }
            if (hi == 0) TL[g * 512 + tl] = m + __builtin_amdgcn_logf(l);
        }
    }
    __threadfence_block();
    __syncthreads();
    {
        const float e0 = TL[tid], e1 = TL[512 + tid], e2 = TL[1024 + tid];
        const float mx = fmaxf(e0, fmaxf(e1, e2));
        float w0 = __builtin_amdgcn_exp2f(e0 - mx), w1 = __builtin_amdgcn_exp2f(e1 - mx), w2 = __builtin_amdgcn_exp2f(e2 - mx);
        const float rs = 1.0f / (w0 + w1 + w2); w0 *= rs; w1 *= rs; w2 *= rs;
        const u32x4* p0 = (const u32x4*)(TO + (size_t)tid * 64); const u32x4* p1 = (const u32x4*)(TO + ((size_t)512 + tid) * 64); const u32x4* p2 = (const u32x4*)(TO + ((size_t)1024 + tid) * 64);
        u32x4* yo = (u32x4*)(YA + ((size_t)b * SEQ + s0 + tid) * 512 + slot * 128);
#pragma unroll
        for (int i = 0; i < 8; ++i) { const u32x4 x0 = p0[i], x1 = p1[i], x2 = p2[i]; u32x4 y;
#pragma unroll
            for (int e = 0; e < 4; ++e) y[e] = cvtpk(w0 * bf_lo(x0[e]) + w1 * bf_lo(x1[e]) + w2 * bf_lo(x2[e]), w0 * bf_hi(x0[e]) + w1 * bf_hi(x1[e]) + w2 * bf_hi(x2[e]));
            yo[i] = y; }
    }
    __syncthreads();
}

__device__ __forceinline__ void phase_attn(KArgs a, LAS unsigned char* lds, int tid, int lane, int wid) {
    const int G = gridDim.x, bx = blockIdx.x; const int vcu = (G % 8 == 0) ? (bx % 8) * (G / 8) + bx / 8 : bx;
    for (int item = vcu; item < 256; item += G) {
        dil_item(a, lds, item, tid, lane, wid);
        const int bh = item >> 3, s = item & 7;
        fox_unit(a, lds, bh >> 2, bh & 3, s, tid, lane, wid);
        fox_unit(a, lds, bh >> 2, bh & 3, 15 - s, tid, lane, wid);
    }
}

#define XB_TMO      128
#define XB_XCNT(j)  (256  + 64 * (j))
#define XB_XSUB(j)  (1280 + 64 * (j))
#define XB_XGEN(j)  (2304 + 64 * (j))
#define XB_TOP      3328
#define XB_TOPGEN   3392
#define XCD_BAR_WORDS 3456
#define XB_SPIN_CAP (1u << 18)
__device__ __forceinline__ unsigned xb_ld(unsigned* p)              { return __hip_atomic_load(p, __ATOMIC_RELAXED, __HIP_MEMORY_SCOPE_AGENT); }
__device__ __forceinline__ unsigned xb_add(unsigned* p, unsigned v) { return __hip_atomic_fetch_add(p, v, __ATOMIC_RELAXED, __HIP_MEMORY_SCOPE_AGENT); }
__device__ __forceinline__ unsigned xb_xcc_id() { return (unsigned)__builtin_amdgcn_s_getreg((3 << 11) | 20) & 0xFu; }
#define XB_SPIN(cond, bar) do { unsigned _sp = 0; while (cond) { __builtin_amdgcn_s_sleep(1); \
    if ((++_sp & 255u) == 0u) { if (xb_ld(&(bar)[XB_TMO])) break; if (_sp > XB_SPIN_CAP) { atomicAdd(&(bar)[XB_TMO], 1u); break; } } } } while (0)
struct XcdBarrier { unsigned* bar; unsigned x; volatile LAS unsigned* st; };
__device__ __forceinline__ XcdBarrier xcd_barrier_post(unsigned* bar, volatile LAS unsigned* st) {
    XcdBarrier b; b.bar = bar; b.x = xb_xcc_id(); b.st = st;
    if (threadIdx.x == 0) (void)xb_add(&bar[XB_XCNT(b.x)], 1u);
    return b;
}
__device__ __forceinline__ void xcd_barrier_complete(unsigned* bar, unsigned x, unsigned& nloc, unsigned& nx) {
    const unsigned G = gridDim.x * gridDim.y * gridDim.z;
    unsigned sum, cnt, mine, sp = 0u;
    for (;;) {
        sum = 0u; cnt = 0u; mine = 0u;
#pragma unroll
        for (unsigned j = 0; j < 16; ++j) { const unsigned c = xb_ld(&bar[XB_XCNT(j)]); sum += c; cnt += (c > 0u) ? 1u : 0u; mine = (j == x) ? c : mine; }
        if (sum == G) break;
        __builtin_amdgcn_s_sleep(1);
        if ((++sp & 255u) == 0u) { if (xb_ld(&bar[XB_TMO])) break; if (sp > XB_SPIN_CAP) { atomicAdd(&bar[XB_TMO], 1u); break; } }
    }
    nloc = mine > 0u ? mine : 1u; nx = cnt > 0u ? cnt : 1u;
}
__device__ __forceinline__ void xcd_barrier(const XcdBarrier& b, const int tid0) {
    asm volatile("s_waitcnt vmcnt(0)" ::: "memory");
    __syncthreads();
    if (tid0 == 0) {
        unsigned* bar = b.bar;
        __builtin_amdgcn_s_waitcnt(0);
        unsigned nloc = b.st[0], nx = b.st[1];
        if (nloc == 0u) { xcd_barrier_complete(bar, b.x, nloc, nx); b.st[0] = nloc; b.st[1] = nx; }
        const unsigned old = xb_add(&bar[XB_XSUB(b.x)], 1u);
        const unsigned gen = old / nloc;
        if (old + 1u == (gen + 1u) * nloc) {
            __builtin_amdgcn_fence(__ATOMIC_RELEASE, "agent");
            asm volatile("s_waitcnt vmcnt(0)" ::: "memory");
            (void)xb_add(&bar[XB_TOP], 1u);
        }
        XB_SPIN(xb_ld(&bar[XB_TOP]) < nx * (gen + 1u), bar);
        __builtin_amdgcn_fence(__ATOMIC_ACQUIRE, "agent");
        asm volatile("s_waitcnt vmcnt(0)" ::: "memory");
    }
    __syncthreads();
}

__global__ void __launch_bounds__(512, 2) mk_fwd(Args karg) {
    extern __shared__ __attribute__((aligned(16))) unsigned char lds_raw[];
    LAS unsigned char* lds = (LAS unsigned char*)lds_raw;
    const int G = gridDim.x, bx = blockIdx.x;
    const int ph_lo = karg.ph_lo, ph_hi = karg.ph_hi;
    const int wid0 = __builtin_amdgcn_readfirstlane((int)threadIdx.x >> 6);
    if (threadIdx.x < 2) ((LAS unsigned*)(lds + LDS_MISC))[16 + threadIdx.x] = 0u;
    __syncthreads();
    const XcdBarrier bar = xcd_barrier_post((unsigned*)(karg.ws + WS_CTL), (volatile LAS unsigned*)(lds + LDS_MISC) + 16);
#pragma unroll 1
    for (int ph = ph_lo; ph < ph_hi; ++ph) {
        if (ph_hi > 1000) cg::this_grid().sync();
        if (ph > ph_lo) xcd_barrier(bar, (wid0 << 6) | (int)__builtin_amdgcn_mbcnt_hi(~0u, __builtin_amdgcn_mbcnt_lo(~0u, 0u)));
        KArgs a = (KArgs)__builtin_amdgcn_kernarg_segment_ptr(); asm volatile("" : "+s"(a));
#define MK_TID() int tid = (wid0 << 6) | (int)__builtin_amdgcn_mbcnt_hi(~0u, __builtin_amdgcn_mbcnt_lo(~0u, 0u)); asm volatile("" : "+v"(tid)); const int lane = tid & 63, wid = wid0
        unsigned char* ws = a->ws;
        bf16_t* H = (bf16_t*)(ws + WS_H); bf16_t* Zb = (bf16_t*)(ws + WS_Z); bf16_t* Y = (bf16_t*)(ws + WS_Y);
        if (ph == 0) { MK_TID(); phase_prologue(a, lds, tid, lane, wid); continue; }
        if (ph == NPHASE - 1) { MK_TID(); phase_norm<3>(a, 0, lds, tid, lane, wid); continue; }
        const int l = (ph - 1) / 8, sp = (ph - 1) % 8;
        if (sp == 0) { MK_TID(); phase_norm<1>(a, l, lds, tid, lane, wid); continue; }
        if (sp == 5) { MK_TID(); phase_norm<2>(a, l, lds, tid, lane, wid); continue; }
        if (sp == 2) { MK_TID(); phase_attn(a, lds, tid, lane, wid); continue; }
        if (sp == 1) { MK_TID(); phase_scan(a, lds, tid, lane, wid); }
        const unsigned char* wl = ws + WS_W + (size_t)l * W_LAYER;
        const float* modl = (const float*)(ws + WS_MOD) + (size_t)l * 8 * NMODC;
        pg8::Gemm g; EpiAny E; int N;
        g.M = T_TOK; g.zskip = 0; E.g = nullptr; E.src = nullptr;
        switch (sp) {
        case 1: g.A = H; g.Bt = (const bf16_t*)(wl + WO_IN); N = ZP; g.K = DM; E.mode = 0; E.dst = Zb; break;
        case 3: g.A = Y; g.Bt = (const bf16_t*)(wl + WO_UP); N = 2 * DM; g.K = 512; g.zskip = 1; E.mode = 1; E.src = Zb + ZO_G; E.dst = H; break;
        case 4: g.A = H; g.Bt = (const bf16_t*)(wl + WO_OUT); N = DM; g.K = DM; E.mode = 3; E.src = (l == 0) ? (const void*)a->in[0] : (const void*)a->out; E.dst = a->out; E.g = modl + 2 * DM; break;
        case 6: g.A = H; g.Bt = (const bf16_t*)(wl + WO_FFI); N = 2 * DFF; g.K = DM; E.mode = 4; E.dst = Zb; break;
        default: g.A = Zb; g.Bt = (const bf16_t*)(wl + WO_FFO); N = DM; g.K = DFF; E.mode = 3; E.src = a->out; E.dst = a->out; E.g = modl + 5 * DM; break;
        }
        g.N = N;
        pg8::StaticOrder S; S.init(T_TOK, N, G, bx, sp == 1 ? 12 : 0);
        if (sp == 3) { MK_TID(); (void)lane; (void)wid; EpiUpOnly EU{Zb + ZO_G, H}; pg8::gemm_phase<EpiUpOnly, pg8::StaticOrder, true, true, true>(lds, g, S, EU, tid); }
        else { MK_TID(); (void)lane; (void)wid; pg8::gemm_phase<EpiAny, pg8::StaticOrder, true, true, false>(lds, g, S, E, tid); }
    }
}

extern "C" void kernel_launch(void* const* d_in, const int* in_sizes, int n_in, void* d_out, int out_size, void* d_ws, size_t ws_size, hipStream_t stream) {
    static int grid = 0;
    if (grid == 0) {
        if (n_in != 14 || in_sizes[0] != T_TOK * DM || out_size != T_TOK * DM || ws_size < WS_END) { fprintf(stderr, "kernel_launch: unexpected shapes / workspace (n_in %d, ws %zu)\n", n_in, ws_size); grid = -1; return; }
        int dev = 0, cus = 0, per_cu = 0;
        if (hipGetDevice(&dev) != hipSuccess || hipDeviceGetAttribute(&cus, hipDeviceAttributeMultiprocessorCount, dev) != hipSuccess) { grid = -1; return; }
        if (hipFuncSetAttribute((const void*)mk_fwd, hipFuncAttributeMaxDynamicSharedMemorySize, LDS_BYTES) != hipSuccess) { fprintf(stderr, "kernel_launch: hipFuncSetAttribute failed\n"); grid = -1; return; }
        if (hipOccupancyMaxActiveBlocksPerMultiprocessor(&per_cu, (const void*)mk_fwd, 512, LDS_BYTES) != hipSuccess || per_cu < 1) { fprintf(stderr, "kernel_launch: occupancy query failed (%d)\n", per_cu); (void)hipGetLastError(); grid = -1; return; }
        grid = cus * 1;
    }
    if (grid < 0) return;
    if (hipMemsetAsync((char*)d_ws + WS_CTL, 0, CTL_BYTES, stream) != hipSuccess) { fprintf(stderr, "kernel_launch: memset of barrier words failed\n"); return; }
    Args a{};
    for (int i = 0; i < 14; ++i) a.in[i] = (const float*)d_in[i];
    a.out = (float*)d_out; a.ws = (unsigned char*)d_ws;
#if MK_MULTI
    for (int ph = 0; ph < NPHASE; ++ph) { a.ph_lo = ph; a.ph_hi = ph + 1; hipLaunchKernelGGL(mk_fwd, dim3(grid), dim3(512), LDS_BYTES, stream, a); }
#else
    a.ph_lo = 0; a.ph_hi = NPHASE;
    void* args[] = {&a};
    hipError_t e = hipLaunchCooperativeKernel((void*)mk_fwd, dim3(grid), dim3(512), args, LDS_BYTES, stream);
    if (e != hipSuccess) fprintf(stderr, "cooperative launch failed: %s (grid %d)\n", hipGetErrorString(e), grid);
#endif
}
```
